# Optimizing an MI355X kernel written in HIP

```python
import math
import jax, jax.numpy as jnp
from jax import lax
import numpy as np

D_MODEL = 2048
BATCH = 4
SEQ = 2048
DEPTH = 2

ATT_HEAD_DIM = D_MODEL // 16
ATT_HEADS = 8
ATT_KV_HEADS = 2
ATT_WIDTH = ATT_HEADS * ATT_HEAD_DIM
ATT_KV_WIDTH = ATT_KV_HEADS * ATT_HEAD_DIM
WINDOW = 128
ATT_BLOCK = 128
ROPE_THETA = 10000.0
M_HEADS = 4
M_V_DIM = D_MODEL // 8
M_QK_DIM = M_V_DIM // 2
M_WIDTH = M_HEADS * M_V_DIM
M_QK_WIDTH = M_HEADS * M_QK_DIM
M_CHUNK = 64
MIX_WIDTH = ATT_WIDTH + M_WIDTH
IN_SIZES = (ATT_WIDTH, ATT_KV_WIDTH, ATT_KV_WIDTH, M_QK_WIDTH, M_QK_WIDTH, M_WIDTH, M_WIDTH, 4 * M_HEADS)
IN_WIDTH = ATT_WIDTH + 2 * ATT_KV_WIDTH + 2 * M_QK_WIDTH + 2 * M_WIDTH + 4 * M_HEADS
N_EXPERTS = 16
EXPERT_FF = D_MODEL // 2
CAPACITY_FACTOR = 2
EPS = 1e-6

kernel_name = "hymba_style_swa_mlstm_ec_moe_encoder"


def rms_norm(x):
    xf = x.astype(jnp.float32)
    return (xf * lax.rsqrt(jnp.mean(xf * xf, axis=-1, keepdims=True) + EPS)).astype(x.dtype)


def split_columns(t, sizes):
    offs = np.cumsum(np.array(sizes))[:-1].tolist()
    return jnp.split(t, offs, axis=-1)


def rope_tables(seq, dim, dtype):
    inv = 1.0 / (ROPE_THETA ** (jnp.arange(0, dim, 2, dtype=jnp.float32) / dim))
    ang = jnp.arange(seq, dtype=jnp.float32)[:, None] * inv[None, :]
    ang = jnp.concatenate([ang, ang], axis=-1)
    return jnp.cos(ang).astype(dtype), jnp.sin(ang).astype(dtype)


def apply_rope(x, cos, sin):
    x1, x2 = jnp.split(x, 2, axis=-1)
    rot = jnp.concatenate([-x2, x1], axis=-1)
    return x * cos[None, :, None, :] + rot * sin[None, :, None, :]


def windowed_gqa(q, k, v, sink):
    B, S, H, Dh = q.shape
    KV = k.shape[2]
    G = H // KV
    L = ATT_BLOCK
    nb = S // L
    qb = q.reshape(B, nb, L, KV, G, Dh)

    def band(t):
        tp = jnp.pad(t, ((0, 0), (L, L), (0, 0), (0, 0)))
        tb = tp.reshape(B, nb + 2, L, KV, Dh)
        return jnp.concatenate([tb[:, :-2], tb[:, 1:-1], tb[:, 2:]], axis=2)

    kb, vb = band(k), band(v)
    scores = jnp.einsum('bnqkgd,bnjkd->bnkgqj', qb, kb).astype(jnp.float32) * (Dh ** -0.5)
    blk = jnp.arange(nb)[:, None, None]
    qpos = blk * L + jnp.arange(L)[None, :, None]
    kpos = (blk - 1) * L + jnp.arange(3 * L)[None, None, :]
    mask = (jnp.abs(kpos - qpos) <= WINDOW) & (kpos >= 0) & (kpos < S)
    scores = jnp.where(mask[None, :, None, None], scores, jnp.finfo(jnp.float32).min)
    sink_col = jnp.broadcast_to(sink.astype(jnp.float32).reshape(1, 1, KV, G, 1, 1), scores.shape[:-1] + (1,))
    probs = jax.nn.softmax(jnp.concatenate([scores, sink_col], axis=-1), axis=-1)[..., :-1]
    out = jnp.einsum('bnkgqj,bnjkd->bnqkgd', probs.astype(v.dtype), vb)
    return out.reshape(B, S, H * Dh)


def mlstm_chunkwise(q, k, v, i_pre, f_pre):
    B, H, S, Dk = q.shape
    Dv = v.shape[-1]
    L = M_CHUNK
    nc = S // L
    q = q.astype(jnp.float32).reshape(B, H, nc, L, Dk) * (Dk ** -0.5)
    k = k.astype(jnp.float32).reshape(B, H, nc, L, Dk)
    v = v.astype(jnp.float32).reshape(B, H, nc, L, Dv)
    logf = jax.nn.log_sigmoid(f_pre.astype(jnp.float32)).reshape(B, H, nc, L)
    ig = i_pre.astype(jnp.float32).reshape(B, H, nc, L)
    b = jnp.cumsum(logf, axis=-1)
    b_tot = b[..., -1]
    lower = jnp.tril(jnp.ones((L, L), dtype=bool))
    dmat = jnp.where(lower, b[..., :, None] - b[..., None, :] + ig[..., None, :], -jnp.inf)
    w_state = b_tot[..., None] - b + ig
    m_loc = jnp.max(w_state, axis=-1)
    ek = jnp.exp(w_state - m_loc[..., None])[..., None] * k
    c_loc = jnp.einsum('bhclk,bhclv->bhckv', ek, v)
    n_loc = jnp.sum(ek, axis=3)

    def step(carry, inp):
        c_st, n_st, m_st = carry
        cl, nl, ml, bt = inp
        m_new = jnp.maximum(bt + m_st, ml)
        a = jnp.exp(bt + m_st - m_new)
        g = jnp.exp(ml - m_new)
        c_new = a[..., None, None] * c_st + g[..., None, None] * cl
        n_new = a[..., None] * n_st + g[..., None] * nl
        return (c_new, n_new, m_new), (c_st, n_st, m_st)

    init = (jnp.zeros((B, H, Dk, Dv), jnp.float32), jnp.zeros((B, H, Dk), jnp.float32),
            jnp.zeros((B, H), jnp.float32))
    xs = (jnp.moveaxis(c_loc, 2, 0), jnp.moveaxis(n_loc, 2, 0), jnp.moveaxis(m_loc, 2, 0), jnp.moveaxis(b_tot, 2, 0))
    _, (c_prev, n_prev, m_prev) = lax.scan(step, init, xs)
    c_prev = jnp.moveaxis(c_prev, 0, 2)
    n_prev = jnp.moveaxis(n_prev, 0, 2)
    m_prev = jnp.moveaxis(m_prev, 0, 2)
    g_inter = b + m_prev[..., None]
    m_t = jnp.maximum(jnp.max(dmat, axis=-1), g_inter)
    e_inter = jnp.exp(g_inter - m_t)
    s = jnp.einsum('bhctk,bhcsk->bhcts', q, k) * jnp.exp(dmat - m_t[..., None])
    num = jnp.einsum('bhcts,bhcsv->bhctv', s, v) + e_inter[..., None] * jnp.einsum('bhctk,bhckv->bhctv', q, c_prev)
    den = jnp.sum(s, axis=-1) + e_inter * jnp.einsum('bhctk,bhck->bhct', q, n_prev)
    h = num / jnp.maximum(jnp.abs(den), jnp.exp(-m_t))[..., None]
    return h.reshape(B, H, S, Dv)


def mlstm_bidirectional(q, k, v, i_fwd, f_fwd, i_bwd, f_bwd):
    flip = lambda t: jnp.flip(t, axis=2)
    h_fwd = mlstm_chunkwise(q, k, v, i_fwd, f_fwd)
    h_bwd = flip(mlstm_chunkwise(flip(q), flip(k), flip(v), flip(i_bwd), flip(f_bwd)))
    return h_fwd + h_bwd


def expert_choice_moe(h, w_router, w_gate, w_up, w_down):
    B, S, D = h.shape
    cap = CAPACITY_FACTOR * S // N_EXPERTS
    aff = jax.nn.softmax((h @ w_router).astype(jnp.float32), axis=-1)
    gates, idx = lax.top_k(jnp.swapaxes(aff, 1, 2), cap)
    xe = jax.vmap(lambda hb, ib: hb[ib])(h, idx)
    hid = jax.nn.silu(jnp.einsum('becd,edf->becf', xe, w_gate)) * jnp.einsum('becd,edf->becf', xe, w_up)
    ye = jnp.einsum('becf,efd->becd', hid, w_down) * gates[..., None].astype(h.dtype)
    flat_idx = (jnp.arange(B)[:, None, None] * S + idx).reshape(-1)
    out = jax.ops.segment_sum(ye.reshape(-1, D), flat_idx, num_segments=B * S)
    return out.reshape(B, S, D)


def hybrid_layer(x, c_act, w_ada, b_ada, w_in, b_gates, q_gain, k_gain, sink, m_gain, w_out,
                 w_router, w_gate, w_up, w_down, cos, sin):
    B, S, _ = x.shape
    mod = (c_act @ w_ada + b_ada)[:, None, :]
    sh1, sc1, g1, sh2, sc2, g2 = jnp.split(mod, 6, axis=-1)
    h = rms_norm(x) * (1 + sc1) + sh1
    aq, ak, av, mq, mk, mv, mo, mg = split_columns(h @ w_in, IN_SIZES)
    aq = rms_norm(aq.reshape(B, S, ATT_HEADS, ATT_HEAD_DIM)) * q_gain
    ak = rms_norm(ak.reshape(B, S, ATT_KV_HEADS, ATT_HEAD_DIM)) * k_gain
    av = av.reshape(B, S, ATT_KV_HEADS, ATT_HEAD_DIM)
    att_out = windowed_gqa(apply_rope(aq, cos, sin), apply_rope(ak, cos, sin), av, sink)
    to_heads = lambda t, d: jnp.transpose(t.reshape(B, S, M_HEADS, d), (0, 2, 1, 3))
    gate_pre = mg.astype(jnp.float32).reshape(B, S, 4, M_HEADS) + b_gates.astype(jnp.float32)
    gate_pre = jnp.transpose(gate_pre, (2, 0, 3, 1))
    hm = mlstm_bidirectional(to_heads(mq, M_QK_DIM), to_heads(mk, M_QK_DIM), to_heads(mv, M_V_DIM),
                             gate_pre[0], gate_pre[2], gate_pre[1], gate_pre[3])
    hm = rms_norm(jnp.transpose(hm, (0, 2, 1, 3))).astype(x.dtype) * m_gain.reshape(M_HEADS, M_V_DIM)
    m_out = hm.reshape(B, S, M_WIDTH) * jax.nn.sigmoid(mo)
    mix = jnp.concatenate([att_out, m_out], axis=-1) @ w_out
    x = x + g1 * mix
    h2 = rms_norm(x) * (1 + sc2) + sh2
    x = x + g2 * expert_choice_moe(h2, w_router, w_gate, w_up, w_down)
    return x


def setup_inputs(seed: int = 0) -> dict:
    key = jax.random.key(seed)
    ks = jax.random.split(key, 16)
    f32 = jnp.float32
    nrm = lambda k, shape, scale: jax.random.normal(k, shape, f32) * scale
    f_bias = jnp.linspace(3.0, 6.0, M_HEADS, dtype=f32)
    gate_noise = nrm(ks[5], (DEPTH, 4, M_HEADS), 0.1)
    b_gates = gate_noise + jnp.stack([jnp.zeros((M_HEADS,), f32), jnp.zeros((M_HEADS,), f32), f_bias, f_bias])[None]
    return {
        "x": nrm(ks[0], (BATCH, SEQ, D_MODEL), 1.0),
        "c": nrm(ks[1], (BATCH, D_MODEL), 1.0),
        "w_ada": nrm(ks[2], (DEPTH, D_MODEL, 6 * D_MODEL), 0.5 * D_MODEL ** -0.5),
        "b_ada": nrm(ks[3], (DEPTH, 6 * D_MODEL), 0.01),
        "w_in": nrm(ks[4], (DEPTH, D_MODEL, IN_WIDTH), D_MODEL ** -0.5),
        "b_gates": b_gates,
        "q_gain": 1.0 + nrm(ks[6], (DEPTH, ATT_HEAD_DIM), 0.1),
        "k_gain": 1.0 + nrm(ks[7], (DEPTH, ATT_HEAD_DIM), 0.1),
        "sink": nrm(ks[8], (DEPTH, ATT_HEADS), 1.0),
        "m_gain": 1.0 + nrm(ks[9], (DEPTH, M_WIDTH), 0.1),
        "w_out": nrm(ks[10], (DEPTH, MIX_WIDTH, D_MODEL), MIX_WIDTH ** -0.5),
        "w_router": nrm(ks[11], (DEPTH, D_MODEL, N_EXPERTS), D_MODEL ** -0.5),
        "w_gate": nrm(ks[12], (DEPTH, N_EXPERTS, D_MODEL, EXPERT_FF), D_MODEL ** -0.5),
        "w_up": nrm(ks[13], (DEPTH, N_EXPERTS, D_MODEL, EXPERT_FF), D_MODEL ** -0.5),
        "w_down": nrm(ks[14], (DEPTH, N_EXPERTS, EXPERT_FF, D_MODEL), EXPERT_FF ** -0.5),
    }


def reference(x, c, w_ada, b_ada, w_in, b_gates, q_gain, k_gain, sink, m_gain, w_out,
              w_router, w_gate, w_up, w_down):
    cos, sin = rope_tables(x.shape[1], ATT_HEAD_DIM, x.dtype)
    c_act = jax.nn.silu(c)
    for l in range(DEPTH):
        x = hybrid_layer(x, c_act, w_ada[l], b_ada[l], w_in[l], b_gates[l], q_gain[l], k_gain[l], sink[l],
                         m_gain[l], w_out[l], w_router[l], w_gate[l], w_up[l], w_down[l], cos, sin)
    return x
```

```cpp
#include <hip/hip_runtime.h>
#include <cstdio>
#include <cstdint>

#ifndef MK_SPLIT
#define MK_SPLIT 1
#endif

#define LAS __attribute__((address_space(3)))
#define DI __device__ __forceinline__
typedef unsigned short bf16_t;
typedef short bf16x8 __attribute__((ext_vector_type(8)));
typedef short s16x4 __attribute__((ext_vector_type(4)));
typedef float f32x2 __attribute__((ext_vector_type(2)));
typedef float f32x4 __attribute__((ext_vector_type(4)));
typedef float f32x16 __attribute__((ext_vector_type(16)));
typedef unsigned u32x2 __attribute__((ext_vector_type(2)));
typedef unsigned u32x4 __attribute__((ext_vector_type(4)));
typedef __bf16 bfv2 __attribute__((ext_vector_type(2)));

constexpr int D = 2048, NB = 4, SEQ = 2048, MTOK = NB * SEQ, DEPTH = 2;
constexpr int INW = 4624, INWG = 4608;
constexpr int C_AQ = 0, C_AK = 1024, C_AV = 1280, C_MQ = 1536, C_MK = 2048, C_MV = 2560, C_MO = 3584, C_MG = 4608;
constexpr int NE = 16, FF = 1024, CAP = 256;
constexpr float EPS = 1e-6f;
constexpr int NWAVES = 8, NTHR = 512;

constexpr size_t al256(size_t x) { return (x + 255) & ~(size_t)255; }
constexpr size_t WS_CTL = 0;
constexpr size_t WS_MOD = 65536;
constexpr size_t MOD_BYTES = (size_t)DEPTH * NB * 6 * D * 4;
constexpr size_t WS_ZERO_END = al256(WS_MOD + MOD_BYTES);
constexpr size_t WS_ROPEC = WS_ZERO_END;
constexpr size_t WS_ROPES = WS_ROPEC + (size_t)SEQ * 64 * 4;
constexpr size_t WS_GATES = WS_ROPES + (size_t)SEQ * 64 * 4;
constexpr size_t WS_AFF = WS_GATES + (size_t)MTOK * 16 * 4;
constexpr size_t WS_SLOT = WS_AFF + (size_t)MTOK * 16 * 4;
constexpr size_t WS_IDX = WS_SLOT + (size_t)MTOK * 16 * 4;
constexpr size_t WS_GATEV = WS_IDX + (size_t)NB * NE * CAP * 4;
constexpr size_t WS_WIN = WS_GATEV + (size_t)NB * NE * CAP * 4;
constexpr size_t WS_WOUT = WS_WIN + (size_t)DEPTH * INWG * D * 2;
constexpr size_t WS_WGU = WS_WOUT + (size_t)DEPTH * D * D * 2;
constexpr size_t WS_WD = WS_WGU + (size_t)DEPTH * NE * 2 * FF * D * 2;
constexpr size_t WS_H = WS_WD + (size_t)DEPTH * NE * D * FF * 2;
constexpr size_t WS_PROJ = WS_H + (size_t)MTOK * D * 2;
constexpr size_t WS_MIX = WS_PROJ + (size_t)MTOK * INWG * 2;
constexpr size_t WS_HF = WS_MIX + (size_t)MTOK * D * 2;
constexpr size_t WS_HB = WS_HF + (size_t)MTOK * 1024 * 4;
constexpr size_t WS_X1 = WS_HB + (size_t)MTOK * 1024 * 4;
constexpr size_t WS_X2 = WS_X1 + (size_t)MTOK * D * 4;
constexpr size_t WS_HID = WS_X2 + (size_t)MTOK * D * 4;
constexpr size_t WS_YE = WS_HID + (size_t)NB * NE * CAP * FF * 2;
constexpr size_t WS_END = WS_YE + (size_t)NB * NE * CAP * D * 2;

constexpr int LDS_STAGE = 131072;
constexpr int LDS_TBL = LDS_STAGE;
constexpr int LDS_MISC = LDS_STAGE + 8192;
constexpr int LDS_BYTES = LDS_STAGE + 8192 + 1024;

DI float bf2f(unsigned b16) { return __uint_as_float(b16 << 16); }
DI unsigned pk2(float lo, float hi) { bfv2 r = __builtin_convertvector((f32x2){lo, hi}, bfv2); return __builtin_bit_cast(unsigned, r); }
DI float shx(float v, int o, int lane) { return __int_as_float(__builtin_amdgcn_ds_bpermute((lane ^ o) << 2, __float_as_int(v))); }
DI float shup(float v, int o, int lane) { const int src = lane >= o ? lane - o : lane; return __int_as_float(__builtin_amdgcn_ds_bpermute(src << 2, __float_as_int(v))); }
DI float rdlane(float v, int l) { return __int_as_float(__builtin_amdgcn_readlane(__float_as_int(v), l)); }
DI float wave_sum(float v, int lane) {
#pragma unroll
    for (int o = 1; o < 64; o <<= 1) v += shx(v, o, lane);
    return v;
}
DI float fast_exp2(float x) { return __builtin_amdgcn_exp2f(x); }
DI float fast_rcp(float x) { return __builtin_amdgcn_rcpf(x); }
#define LDS_WAIT() asm volatile("s_waitcnt lgkmcnt(0)" ::: "memory")
#define VM_WAIT() asm volatile("s_waitcnt vmcnt(0)" ::: "memory")
constexpr float LOG2E = 1.4426950408889634f;

#define XB_TMO      128
#define XB_XCNT(j)  (256  + 64 * (j))
#define XB_XSUB(j)  (1280 + 64 * (j))
#define XB_XGEN(j)  (2304 + 64 * (j))
#define XB_TOP      3328
#define XB_TOPGEN   3392
#define XCD_BAR_WORDS 3456
#define XB_SPIN_CAP (1u << 18)

DI unsigned xb_ld(unsigned* p)              { return __hip_atomic_load(p, __ATOMIC_RELAXED, __HIP_MEMORY_SCOPE_AGENT); }
DI unsigned xb_add(unsigned* p, unsigned v) { return __hip_atomic_fetch_add(p, v, __ATOMIC_RELAXED, __HIP_MEMORY_SCOPE_AGENT); }
DI unsigned xb_xcc_id() { return (unsigned)__builtin_amdgcn_s_getreg((3 << 11) | 20) & 0xFu; }
#define XB_SPIN(cond, bar) do { unsigned _sp = 0; while (cond) { __builtin_amdgcn_s_sleep(1); \
    if ((++_sp & 255u) == 0u) { if (xb_ld(&(bar)[XB_TMO])) break; if (_sp > XB_SPIN_CAP) { atomicAdd(&(bar)[XB_TMO], 1u); break; } } } } while (0)

struct XcdBarrier { unsigned* bar; unsigned x; volatile LAS unsigned* st; };

DI XcdBarrier xcd_barrier_post(unsigned* bar, volatile LAS unsigned* st) {
    XcdBarrier b; b.bar = bar; b.x = xb_xcc_id(); b.st = st;
    if (threadIdx.x == 0) (void)xb_add(&bar[XB_XCNT(b.x)], 1u);
    return b;
}
DI void xcd_barrier_complete(unsigned* bar, unsigned x, unsigned& nloc, unsigned& nx) {
    const unsigned G = gridDim.x * gridDim.y * gridDim.z;
    unsigned sum, cnt, sp = 0u;
    for (;;) {
        sum = 0u; cnt = 0u;
#pragma unroll 1
        for (unsigned j = 0; j < 16; ++j) { const unsigned c = xb_ld(&bar[XB_XCNT(j)]); sum += c; cnt += (c > 0u) ? 1u : 0u; }
        if (sum == G) break;
        __builtin_amdgcn_s_sleep(1);
        if ((++sp & 255u) == 0u) { if (xb_ld(&bar[XB_TMO])) break; if (sp > XB_SPIN_CAP) { atomicAdd(&bar[XB_TMO], 1u); break; } }
    }
    const unsigned mine = xb_ld(&bar[XB_XCNT(x)]);
    nloc = mine > 0u ? mine : 1u; nx = cnt > 0u ? cnt : 1u;
}
DI void xcd_barrier(const XcdBarrier& b) {
    asm volatile("s_waitcnt vmcnt(0)" ::: "memory");
    __syncthreads();
    if (threadIdx.x == 0) {
        unsigned* bar = b.bar; unsigned bx = b.x;
        asm volatile("" : "+s"(bar), "+s"(bx));
        __builtin_amdgcn_s_waitcnt(0);
        unsigned nloc = b.st[0], nx = b.st[1];
        if (nloc == 0u) { xcd_barrier_complete(bar, bx, nloc, nx); b.st[0] = nloc; b.st[1] = nx; }
        const unsigned old = xb_add(&bar[XB_XSUB(bx)], 1u);
        const unsigned gen = old / nloc;
        if (old + 1u == (gen + 1u) * nloc) {
            __builtin_amdgcn_fence(__ATOMIC_RELEASE, "agent");
            asm volatile("s_waitcnt vmcnt(0)" ::: "memory");
            const unsigned og = xb_add(&bar[XB_TOP], 1u);
            const unsigned tg = og / nx;
            if (og + 1u == (tg + 1u) * nx) xb_add(&bar[XB_TOPGEN], 1u);
            else XB_SPIN(xb_ld(&bar[XB_TOPGEN]) == tg, bar);
            __builtin_amdgcn_fence(__ATOMIC_ACQUIRE, "agent");
            xb_add(&bar[XB_XGEN(bx)], 1u);
            asm volatile("s_waitcnt vmcnt(0)" ::: "memory");
        } else {
            XB_SPIN(xb_ld(&bar[XB_XGEN(bx)]) == gen, bar);
            __builtin_amdgcn_fence(__ATOMIC_ACQUIRE, "agent");
            asm volatile("s_waitcnt vmcnt(0)" ::: "memory");
        }
    }
    __syncthreads();
}

namespace pg8 {
constexpr int BM = 256, BK = 64, HALF = 128, HTB = HALF * BK * 2, STAGE_BYTES = 8 * HTB, NXCD = 8, WGM = 8;
DI int lds_byte(int r, int c) { const int st = (r >> 4) * 2 + (c >> 5), rr = r & 15, cc = c & 31, ob = rr * 64 + cc * 2; return st * 1024 + (ob ^ (((ob >> 9) & 1) << 5)); }
DI void stage_rc(int b, int& R, int& C) { const int st = b / 1024, sb = b % 1024, swz = sb ^ (((sb >> 9) & 1) << 5); R = (st >> 1) * 16 + swz / 64; C = (st & 1) * 32 + (swz % 64) / 2; }
DI int perm32(int rho) { const int n = rho >> 4, i = rho & 15; return 8 * (i >> 2) + 4 * n + (i & 3); }
struct Unit { int pm, pn, aux; };

template <int K, class Epi, class Sched>
DI void gemm_phase(LAS unsigned char* lds, const int tid, const Sched& S, const Epi& E) {
    const int wid = __builtin_amdgcn_readfirstlane(tid >> 6), lane = tid & 63, wr = wid >> 2, wc = wid & 3, fr = lane & 15, fq = lane >> 4;
    constexpr int nt = K / BK;
    int R[2], C[2]; unsigned voffB[2];
#pragma unroll
    for (int i = 0; i < 2; ++i) { stage_rc(tid * 16 + i * 8192, R[i], C[i]); const int Rb = Epi::PERM ? ((R[i] & ~31) + perm32(R[i] & 31)) : R[i]; voffB[i] = (unsigned)(Rb * K + C[i]) * 2u; }
    constexpr size_t kstep = (size_t)(BK * 2);
    constexpr size_t hstep = (size_t)HALF * K * 2;
    const unsigned ldsw = (unsigned)wid * 1024u;
    const int aoff = lds_byte(wr * 64 + fr, fq * 8), boff = lds_byte(wc * 32 + fr, fq * 8);
#define PG8_SA(b, h) (((b) * 2 + (h)) * HTB)
#define PG8_SB(b, h) ((4 + (b) * 2 + (h)) * HTB)
#define PG8_STAGE(bufoff, gbase, voff) do { _Pragma("unroll") for (int _i = 0; _i < 2; ++_i) \
        __builtin_amdgcn_global_load_lds((const unsigned*)((const char*)(gbase) + (voff)[_i]), (LAS unsigned*)(lds + (bufoff) + ldsw + _i * 8192), 16, 0, 0); } while (0)
#define PG8_LDA(dst, b, h) do { _Pragma("unroll") for (int m = 0; m < 4; ++m) _Pragma("unroll") for (int k = 0; k < 2; ++k) dst[m][k] = *(const LAS bf16x8*)(lds + PG8_SA(b, h) + aoff + m * 2048 + k * 1024); } while (0)
#define PG8_LDB(dst, b, h) do { _Pragma("unroll") for (int n = 0; n < 2; ++n) _Pragma("unroll") for (int k = 0; k < 2; ++k) dst[n][k] = *(const LAS bf16x8*)(lds + PG8_SB(b, h) + boff + n * 2048 + k * 1024); } while (0)
#define PG8_MMA(ai, bj, At, Bt) do { __builtin_amdgcn_s_setprio(1); _Pragma("unroll") for (int m = 0; m < 4; ++m) _Pragma("unroll") for (int n = 0; n < 2; ++n) _Pragma("unroll") for (int k = 0; k < 2; ++k) \
        acc[ai][bj][m][n] = __builtin_amdgcn_mfma_f32_16x16x32_bf16(Bt[n][k], At[m][k], acc[ai][bj][m][n], 0, 0, 0); __builtin_amdgcn_s_setprio(0); } while (0)
#define PG8_WAIT_V(n) asm volatile("s_waitcnt vmcnt(" #n ")" ::: "memory")
#define PG8_WAIT_L(n) asm volatile("s_waitcnt lgkmcnt(" #n ")" ::: "memory")
#define PG8_BAR __builtin_amdgcn_s_barrier()
#define PG8_SCHED __builtin_amdgcn_sched_barrier(0)
    Unit cur, nxt; int ui = 0;
    if (!S.next(0, cur)) return;
    f32x4 acc[2][2][4][2];
#pragma unroll
    for (int a = 0; a < 2; ++a)
#pragma unroll
        for (int b = 0; b < 2; ++b)
#pragma unroll
            for (int m = 0; m < 4; ++m)
#pragma unroll
                for (int n = 0; n < 2; ++n) acc[a][b][m][n] = (f32x4){0.f, 0.f, 0.f, 0.f};
    bf16x8 At[4][2], B0[2][2], B1[2][2];
    unsigned vA0[2], vA1[2], vN0[2], vN1[2];
    S.a_off(cur, 0, R, C, vA0, vA1);
    const char* cA = S.a_ptr(cur); const char* cB = S.b_ptr(cur);
    PG8_STAGE(PG8_SB(0, 0), cB, voffB); PG8_STAGE(PG8_SA(0, 0), cA, vA0); PG8_STAGE(PG8_SB(0, 1), cB + hstep, voffB); PG8_STAGE(PG8_SA(0, 1), cA, vA1);
    if (wr == 1) PG8_BAR;
    PG8_WAIT_V(4); PG8_BAR;
    PG8_STAGE(PG8_SB(1, 0), cB + kstep, voffB); PG8_STAGE(PG8_SA(1, 0), cA + kstep, vA0); PG8_STAGE(PG8_SB(1, 1), cB + hstep + kstep, voffB);
    PG8_WAIT_V(6); PG8_BAR;
    for (;;) {
        const bool has_next = S.next(ui + 1, nxt);
        const char* nA = has_next ? S.a_ptr(nxt) : cA; const char* nB = has_next ? S.b_ptr(nxt) : cB;
        if (has_next) S.a_off(nxt, ui + 1, R, C, vN0, vN1); else { vN0[0] = vA0[0]; vN0[1] = vA0[1]; vN1[0] = vA1[0]; vN1[1] = vA1[1]; }
        for (int t = 0; t < nt; t += 2) {
            const bool last = (t == nt - 2);
            const char* a1 = cA + (size_t)(t + 1) * kstep;
            const char* a2 = last ? nA : cA + (size_t)(t + 2) * kstep; const char* b2 = last ? nB : cB + (size_t)(t + 2) * kstep;
            const char* a3 = a2 + kstep; const char* b3 = b2 + kstep;
            PG8_LDB(B0, 0, 0); PG8_SCHED; PG8_LDA(At, 0, 0); PG8_STAGE(PG8_SA(1, 1), a1, vA1);
            if (last) { vA0[0] = vN0[0]; vA0[1] = vN0[1]; vA1[0] = vN1[0]; vA1[1] = vN1[1]; }
            PG8_WAIT_L(8); PG8_BAR; PG8_WAIT_L(0); PG8_MMA(0, 0, At, B0); PG8_BAR; PG8_SCHED;
            PG8_LDB(B1, 0, 1); PG8_STAGE(PG8_SB(0, 0), b2, voffB);
            PG8_BAR; PG8_WAIT_L(0); PG8_MMA(0, 1, At, B1); PG8_BAR;
            PG8_LDA(At, 0, 1); PG8_STAGE(PG8_SA(0, 0), a2, vA0);
            PG8_BAR; PG8_WAIT_L(0); PG8_MMA(1, 0, At, B0); PG8_BAR; PG8_SCHED;
            PG8_STAGE(PG8_SB(0, 1), b2 + hstep, voffB);
            PG8_WAIT_V(6); PG8_BAR; PG8_MMA(1, 1, At, B1); PG8_BAR;
            PG8_LDB(B0, 1, 0); PG8_SCHED; PG8_LDA(At, 1, 0); PG8_STAGE(PG8_SA(0, 1), a2, vA1);
            PG8_WAIT_L(8); PG8_BAR; PG8_WAIT_L(0); PG8_MMA(0, 0, At, B0); PG8_BAR; PG8_SCHED;
            PG8_LDB(B1, 1, 1); PG8_STAGE(PG8_SB(1, 0), b3, voffB);
            PG8_BAR; PG8_WAIT_L(0); PG8_MMA(0, 1, At, B1); PG8_BAR;
            PG8_LDA(At, 1, 1); PG8_STAGE(PG8_SA(1, 0), a3, vA0);
            PG8_BAR; PG8_WAIT_L(0); PG8_MMA(1, 0, At, B0); PG8_BAR; PG8_SCHED;
            PG8_STAGE(PG8_SB(1, 1), b3 + hstep, voffB);
            PG8_WAIT_V(6); PG8_BAR; PG8_MMA(1, 1, At, B1); PG8_BAR;
        }
        E(acc, cur, wr, wc, fr, fq);
        if (!has_next) break;
#pragma unroll
        for (int a = 0; a < 2; ++a)
#pragma unroll
            for (int b = 0; b < 2; ++b)
#pragma unroll
                for (int m = 0; m < 4; ++m)
#pragma unroll
                    for (int n = 0; n < 2; ++n) acc[a][b][m][n] = (f32x4){0.f, 0.f, 0.f, 0.f};
        cur = nxt; cA = nA; cB = nB; ++ui;
    }
    PG8_WAIT_V(0);
    if (wr == 0) PG8_BAR;
    PG8_BAR;
#undef PG8_SA
#undef PG8_SB
#undef PG8_STAGE
#undef PG8_LDA
#undef PG8_LDB
#undef PG8_MMA
#undef PG8_WAIT_V
#undef PG8_WAIT_L
#undef PG8_BAR
#undef PG8_SCHED
}

DI bool static_unit(int nM, int nN, int G, int c, int i, int& pm, int& pn) {
    const int nwg = nM * nN; const long L = (long)i * G + c; if (L >= nwg) return false;
    int wgid = (int)L; { const int q = nwg / NXCD, r = nwg % NXCD, xcd = wgid % NXCD, off = wgid / NXCD; wgid = (xcd < r ? xcd * (q + 1) : r * (q + 1) + (xcd - r) * q) + off; }
    const int nig = WGM * nN, gid = wgid / nig, fm = gid * WGM, gsz = (nM - fm) < WGM ? (nM - fm) : WGM;
    pm = fm + ((wgid % nig) % gsz); pn = (wgid % nig) / gsz; return true;
}
template <int K> struct SchedPlain {
    const bf16_t* A; const bf16_t* Bt; int nM, nN, G, c;
    DI bool next(int i, Unit& u) const { u.aux = 0; return static_unit(nM, nN, G, c, i, u.pm, u.pn); }
    DI const char* a_ptr(const Unit& u) const { return (const char*)A + (size_t)u.pm * BM * K * 2; }
    DI const char* b_ptr(const Unit& u) const { return (const char*)Bt + (size_t)u.pn * BM * K * 2; }
    DI void a_off(const Unit&, int, const int (&R)[2], const int (&C)[2], unsigned (&v0)[2], unsigned (&v1)[2]) const {
#pragma unroll
        for (int i = 0; i < 2; ++i) { v0[i] = (unsigned)(R[i] * K + C[i]) * 2u; v1[i] = (unsigned)((R[i] + HALF) * K + C[i]) * 2u; }
    }
};
DI bool moe_unit(int G, int c, int i, Unit& u) {
    const int L = i * G + c; if (L >= NB * NE * 8) return false;
    const int wgid = (L % NXCD) * (NB * NE * 8 / NXCD) + L / NXCD;
    const int e = wgid >> 5, ntile = (wgid >> 2) & 7, b = wgid & 3;
    u.pm = b * NE + e; u.pn = ntile; u.aux = e; return true;
}
struct SchedMoeUp {
    const bf16_t* Hm; const bf16_t* W; const LAS int* tbl; int G, c;
    DI bool next(int i, Unit& u) const { return moe_unit(G, c, i, u); }
    DI const char* a_ptr(const Unit&) const { return (const char*)Hm; }
    DI const char* b_ptr(const Unit& u) const { return (const char*)W + ((size_t)u.aux * 2 * FF + (size_t)u.pn * BM) * D * 2; }
    DI void a_off(const Unit&, int i, const int (&R)[2], const int (&C)[2], unsigned (&v0)[2], unsigned (&v1)[2]) const {
#pragma unroll
        for (int j = 0; j < 2; ++j) { const int r0 = tbl[i * 256 + R[j]], r1 = tbl[i * 256 + HALF + R[j]];
            v0[j] = (unsigned)(r0 * D + C[j]) * 2u; v1[j] = (unsigned)(r1 * D + C[j]) * 2u; }
    }
};
struct SchedMoeDown {
    const bf16_t* Hid; const bf16_t* W; int G, c;
    DI bool next(int i, Unit& u) const { return moe_unit(G, c, i, u); }
    DI const char* a_ptr(const Unit& u) const { return (const char*)Hid + (size_t)u.pm * BM * FF * 2; }
    DI const char* b_ptr(const Unit& u) const { return (const char*)W + ((size_t)u.aux * D + (size_t)u.pn * BM) * FF * 2; }
    DI void a_off(const Unit&, int, const int (&R)[2], const int (&C)[2], unsigned (&v0)[2], unsigned (&v1)[2]) const {
#pragma unroll
        for (int i = 0; i < 2; ++i) { v0[i] = (unsigned)(R[i] * FF + C[i]) * 2u; v1[i] = (unsigned)((R[i] + HALF) * FF + C[i]) * 2u; }
    }
};

DI unsigned cvt_pk_bf16(float lo, float hi) { unsigned r; asm volatile("v_cvt_pk_bf16_f32 %0, %1, %2" : "=v"(r) : "v"(lo), "v"(hi)); return r; }

struct EpiStoreBf16 {
    static constexpr bool PERM = true;
    bf16_t* O; int ldc;
    DI void operator()(const f32x4 (&acc)[2][2][4][2], const Unit& u, int wr, int wc, int fr, int fq) const {
        const int row0 = u.pm * BM + wr * 64 + fr, col0 = u.pn * BM + wc * 32 + 8 * fq;
#pragma unroll
        for (int ai = 0; ai < 2; ++ai)
#pragma unroll
            for (int m = 0; m < 4; ++m) { bf16_t* rowp = O + (size_t)(row0 + ai * HALF + m * 16) * ldc + col0;
#pragma unroll
                for (int bj = 0; bj < 2; ++bj) { const f32x4 v0 = acc[ai][bj][m][0], v1 = acc[ai][bj][m][1];
                    u32x4 w; w.x = cvt_pk_bf16(v0[0], v0[1]); w.y = cvt_pk_bf16(v0[2], v0[3]); w.z = cvt_pk_bf16(v1[0], v1[1]); w.w = cvt_pk_bf16(v1[2], v1[3]);
                    *(u32x4*)(rowp + bj * HALF) = w; } }
    }
};
struct EpiResidual {
    static constexpr bool PERM = false;
    const float* Xin; float* Out; const float* g;
    DI void operator()(const f32x4 (&acc)[2][2][4][2], const Unit& u, int wr, int wc, int fr, int fq) const {
        const int row0 = u.pm * BM + wr * 64 + fr, col0 = u.pn * BM + wc * 32 + 4 * fq;
        const float* gb = g + (size_t)(u.pm / (SEQ / BM)) * 6 * D + col0;
        f32x4 gv[2][2];
#pragma unroll
        for (int bj = 0; bj < 2; ++bj)
#pragma unroll
            for (int n = 0; n < 2; ++n) gv[bj][n] = *(const f32x4*)(gb + bj * HALF + n * 16);
#pragma unroll
        for (int ai = 0; ai < 2; ++ai)
#pragma unroll
            for (int m = 0; m < 4; ++m) { const size_t ro = (size_t)(row0 + ai * HALF + m * 16) * D + col0;
#pragma unroll
                for (int bj = 0; bj < 2; ++bj)
#pragma unroll
                    for (int n = 0; n < 2; ++n) { const f32x4 xv = *(const f32x4*)(Xin + ro + bj * HALF + n * 16);
                        *(f32x4*)(Out + ro + bj * HALF + n * 16) = xv + gv[bj][n] * acc[ai][bj][m][n]; } }
    }
};
struct EpiSwiGLU {
    static constexpr bool PERM = true;
    bf16_t* Hid;
    DI void operator()(const f32x4 (&acc)[2][2][4][2], const Unit& u, int wr, int wc, int fr, int fq) const {
        const int row0 = u.pm * BM + wr * 64 + fr, col0 = u.pn * HALF + wc * 32 + 8 * fq;
#pragma unroll
        for (int ai = 0; ai < 2; ++ai)
#pragma unroll
            for (int m = 0; m < 4; ++m) { bf16_t* rowp = Hid + (size_t)(row0 + ai * HALF + m * 16) * FF + col0;
                float h[8];
#pragma unroll
                for (int n = 0; n < 2; ++n)
#pragma unroll
                    for (int j = 0; j < 4; ++j) { const float gg = acc[ai][0][m][n][j], uu = acc[ai][1][m][n][j];
                        h[n * 4 + j] = gg * fast_rcp(1.0f + fast_exp2(-gg * LOG2E)) * uu; }
                u32x4 w; w.x = cvt_pk_bf16(h[0], h[1]); w.y = cvt_pk_bf16(h[2], h[3]); w.z = cvt_pk_bf16(h[4], h[5]); w.w = cvt_pk_bf16(h[6], h[7]);
                *(u32x4*)rowp = w; }
    }
};
struct EpiGated {
    static constexpr bool PERM = true;
    bf16_t* O; const float* gate;
    DI void operator()(const f32x4 (&acc)[2][2][4][2], const Unit& u, int wr, int wc, int fr, int fq) const {
        const int row0 = u.pm * BM + wr * 64 + fr, col0 = u.pn * BM + wc * 32 + 8 * fq;
#pragma unroll
        for (int ai = 0; ai < 2; ++ai)
#pragma unroll
            for (int m = 0; m < 4; ++m) { const int row = row0 + ai * HALF + m * 16; const float gt = gate[row]; bf16_t* rowp = O + (size_t)row * D + col0;
#pragma unroll
                for (int bj = 0; bj < 2; ++bj) { const f32x4 v0 = acc[ai][bj][m][0] * gt, v1 = acc[ai][bj][m][1] * gt;
                    u32x4 w; w.x = cvt_pk_bf16(v0[0], v0[1]); w.y = cvt_pk_bf16(v0[2], v0[3]); w.z = cvt_pk_bf16(v1[0], v1[1]); w.w = cvt_pk_bf16(v1[2], v1[3]);
                    *(u32x4*)(rowp + bj * HALF) = w; } }
    }
};
}

struct Frame { LAS unsigned char* lds; int tid, lane, wave, G, bid; };
#define MFMA16(a, b, c) __builtin_amdgcn_mfma_f32_16x16x32_bf16((a), (b), (c), 0, 0, 0)
#define MFMA32(a, b, c) __builtin_amdgcn_mfma_f32_32x32x16_bf16((a), (b), (c), 0, 0, 0)

DI void unpack8(const u32x4 raw, float (&x)[8]) {
#pragma unroll
    for (int i = 0; i < 4; ++i) { x[2 * i] = __uint_as_float(raw[i] << 16); x[2 * i + 1] = __uint_as_float(raw[i] & 0xffff0000u); }
}
DI u32x4 pack8(const float (&x)[8]) { u32x4 w; w.x = pk2(x[0], x[1]); w.y = pk2(x[2], x[3]); w.z = pk2(x[4], x[5]); w.w = pk2(x[6], x[7]); return w; }

DI void transpose_item(const float* W, int ldw, bf16_t* WT, int K, int dst_row, int k0, int n0, LAS float* scr, int lane) {
#pragma unroll 8
    for (int i = 0; i < 32; ++i) { const int kk = 2 * i + (lane >> 5); scr[kk * 33 + (lane & 31)] = W[(size_t)(k0 + kk) * ldw + n0 + (lane & 31)]; }
    LDS_WAIT();
    const int c = lane & 7;
#pragma unroll
    for (int j = 0; j < 4; ++j) { const int n = (lane >> 3) + 8 * j; const LAS float* s = scr + (8 * c) * 33 + n;
        u32x4 o; o.x = pk2(s[0 * 33], s[1 * 33]); o.y = pk2(s[2 * 33], s[3 * 33]); o.z = pk2(s[4 * 33], s[5 * 33]); o.w = pk2(s[6 * 33], s[7 * 33]);
        *(u32x4*)(WT + (size_t)(dst_row + n) * K + k0 + 8 * c) = o; }
    LDS_WAIT();
}
struct Ptrs {
    const float *x, *c, *w_ada, *b_ada, *w_in, *b_gates, *q_gain, *k_gain, *sink, *m_gain, *w_out, *w_router, *w_gate, *w_up, *w_down;
    float* out; unsigned char* ws;
};
DI void p0_prologue(Frame& F, const Ptrs& P) {
    unsigned char* ws = P.ws;
    {
        LAS float* scr = (LAS float*)(F.lds + F.wave * 16384);
        const int gw = F.bid * NWAVES + F.wave, NGW = F.G * NWAVES;
        constexpr int I_IN = (D / 64) * (INWG / 32), I_OUT = (D / 64) * (D / 32), I_GE = (D / 64) * (FF / 32), I_G = NE * I_GE, I_DE = (FF / 64) * (D / 32), I_D = NE * I_DE;
        constexpr int PER_LAYER = I_IN + I_OUT + 2 * I_G + I_D;
        for (int it = gw; it < DEPTH * PER_LAYER; it += NGW) {
            const int l = it / PER_LAYER; int r = it % PER_LAYER;
            if (r < I_IN) { const int kb = r / (INWG / 32), nb = r % (INWG / 32);
                transpose_item(P.w_in + (size_t)l * D * INW, INW, (bf16_t*)(ws + WS_WIN) + (size_t)l * INWG * D, D, 32 * nb, 64 * kb, 32 * nb, scr, F.lane); continue; }
            r -= I_IN;
            if (r < I_OUT) { const int kb = r / (D / 32), nb = r % (D / 32);
                transpose_item(P.w_out + (size_t)l * D * D, D, (bf16_t*)(ws + WS_WOUT) + (size_t)l * D * D, D, 32 * nb, 64 * kb, 32 * nb, scr, F.lane); continue; }
            r -= I_OUT;
            if (r < 2 * I_G) { const int up = r >= I_G; if (up) r -= I_G;
                const int e = r / I_GE, q = r % I_GE, kb = q / (FF / 32), nb = q % (FF / 32), n0 = 32 * nb;
                const float* src = (up ? P.w_up : P.w_gate) + (size_t)(l * NE + e) * D * FF;
                transpose_item(src, FF, (bf16_t*)(ws + WS_WGU) + (size_t)(l * NE + e) * 2 * FF * D, D, (n0 / 128) * 256 + (n0 % 128) + (up ? 128 : 0), 64 * kb, n0, scr, F.lane); continue; }
            r -= 2 * I_G;
            { const int e = r / I_DE, q = r % I_DE, kb = q / (D / 32), nb = q % (D / 32);
                transpose_item(P.w_down + (size_t)(l * NE + e) * FF * D, D, (bf16_t*)(ws + WS_WD) + (size_t)(l * NE + e) * D * FF, FF, 32 * nb, 64 * kb, 32 * nb, scr, F.lane); }
        }
    }
    {
        float* rc = (float*)(ws + WS_ROPEC); float* rs = (float*)(ws + WS_ROPES);
        for (int idx = F.bid * NTHR + F.tid; idx < SEQ * 64; idx += F.G * NTHR) {
            const int pos = idx >> 6, j = idx & 63;
            const float pw = (float)exp(9.210340371976184 * ((double)j / 64.0));
            const float inv = 1.0f / pw;
            const float ang = (float)pos * inv;
            rc[idx] = (float)cos((double)ang); rs[idx] = (float)sin((double)ang);
        }
    }
    __syncthreads();
    {
        LAS float* cact = (LAS float*)F.lds;
        LAS float* red = (LAS float*)(F.lds + 32768);
        for (int i = F.tid; i < NB * D; i += NTHR) { const float v = P.c[i]; cact[i] = v / (1.0f + expf(-v)); }
        __syncthreads();
        float* MOD = (float*)(ws + WS_MOD);
        for (int task = F.bid; task < DEPTH * 48 * 8; task += F.G) {
            const int l = task / 384, r = task % 384, nc = r >> 3, kc = r & 7;
            const int n = nc * 256 + F.lane * 4;
            f32x4 acc[NB];
#pragma unroll
            for (int b = 0; b < NB; ++b) acc[b] = (f32x4){0.f, 0.f, 0.f, 0.f};
            const float* wp = P.w_ada + ((size_t)l * D + kc * 256 + F.wave * 32) * (6 * D) + n;
#pragma unroll 8
            for (int i = 0; i < 32; ++i) { const f32x4 w = *(const f32x4*)(wp + (size_t)i * 6 * D); const int k = kc * 256 + F.wave * 32 + i;
#pragma unroll
                for (int b = 0; b < NB; ++b) acc[b] += w * cact[b * D + k]; }
#pragma unroll
            for (int b = 0; b < NB; ++b) *(LAS f32x4*)(red + (F.wave * NB + b) * 256 + F.lane * 4) = acc[b];
            __syncthreads();
            for (int o = F.tid; o < NB * 256; o += NTHR) { const int b = o >> 8, nn = o & 255; float s = 0.f;
#pragma unroll
                for (int w = 0; w < 8; ++w) s += red[(w * NB + b) * 256 + nn];
                if (kc == 0) s += P.b_ada[(size_t)l * 6 * D + nc * 256 + nn];
                atomicAdd(MOD + ((size_t)l * NB + b) * 6 * D + nc * 256 + nn, s); }
            __syncthreads();
        }
    }
}

DI float reduce16(float (&a)[16], int lane) {
#pragma unroll
    for (int i = 0; i < 8; ++i) { const float send = (lane & 32) ? a[i] : a[i + 8], keep = (lane & 32) ? a[i + 8] : a[i]; a[i] = keep + shx(send, 32, lane); }
#pragma unroll
    for (int i = 0; i < 4; ++i) { const float send = (lane & 16) ? a[i] : a[i + 4], keep = (lane & 16) ? a[i + 4] : a[i]; a[i] = keep + shx(send, 16, lane); }
#pragma unroll
    for (int i = 0; i < 2; ++i) { const float send = (lane & 8) ? a[i] : a[i + 2], keep = (lane & 8) ? a[i + 2] : a[i]; a[i] = keep + shx(send, 8, lane); }
    { const float send = (lane & 4) ? a[0] : a[1], keep = (lane & 4) ? a[1] : a[0]; a[0] = keep + shx(send, 4, lane); }
    float v = a[0]; v += shx(v, 1, lane); v += shx(v, 2, lane);
    return v;
}
template <int MODE>
DI void norm_phase(Frame& F, const float* xin, const float* mod_sh, const float* mod_sc, const float* W16, int ldw16, const float* bias16, bf16_t* Hout, float* out16) {
    LAS float* wt = (LAS float*)F.lds;
    for (int idx = F.tid; idx < D * 16; idx += NTHR) { const int k = idx >> 4, n = idx & 15; wt[n * D + k] = W16[(size_t)k * ldw16 + n]; }
    __syncthreads();
    const int gw = F.bid * NWAVES + F.wave, NGW = F.G * NWAVES, lane = F.lane;
    const int nmap = ((lane >> 5) & 1) * 8 + ((lane >> 4) & 1) * 4 + ((lane >> 3) & 1) * 2 + ((lane >> 2) & 1);
    for (int grp = gw; grp < MTOK / 2; grp += NGW) {
        f32x4 v[2][8];
#pragma unroll
        for (int rr = 0; rr < 2; ++rr) {
            const int row = 2 * grp + rr, b = row / SEQ;
            const float* xr = xin + (size_t)row * D + 4 * lane;
            float ss = 0.f;
#pragma unroll
            for (int j = 0; j < 8; ++j) { v[rr][j] = *(const f32x4*)(xr + 256 * j); ss += (v[rr][j].x * v[rr][j].x + v[rr][j].y * v[rr][j].y) + (v[rr][j].z * v[rr][j].z + v[rr][j].w * v[rr][j].w); }
            ss = wave_sum(ss, lane);
            const float rstd = 1.0f / sqrtf(ss * (1.0f / D) + EPS);
            const float* shp = mod_sh + (size_t)b * 6 * D + 4 * lane; const float* scp = mod_sc + (size_t)b * 6 * D + 4 * lane;
            bf16_t* hr = Hout + (size_t)row * D + 4 * lane;
#pragma unroll
            for (int j = 0; j < 8; ++j) { const f32x4 sh = *(const f32x4*)(shp + 256 * j), sc = *(const f32x4*)(scp + 256 * j);
                v[rr][j] = v[rr][j] * rstd * (sc + 1.0f) + sh;
                u32x2 o; o.x = pk2(v[rr][j].x, v[rr][j].y); o.y = pk2(v[rr][j].z, v[rr][j].w); *(u32x2*)(hr + 256 * j) = o; }
        }
        float a0[16], a1[16];
#pragma unroll
        for (int n = 0; n < 16; ++n) { float s0 = 0.f, s1 = 0.f;
#pragma unroll
            for (int j = 0; j < 8; ++j) { const f32x4 w = *(const LAS f32x4*)(wt + n * D + 256 * j + 4 * lane);
                s0 += (v[0][j].x * w.x + v[0][j].y * w.y) + (v[0][j].z * w.z + v[0][j].w * w.w);
                s1 += (v[1][j].x * w.x + v[1][j].y * w.y) + (v[1][j].z * w.z + v[1][j].w * w.w); }
            a0[n] = s0; a1[n] = s1; asm volatile("" ::: "memory"); }
        float r0 = reduce16(a0, lane), r1 = reduce16(a1, lane);
#pragma unroll
        for (int rr = 0; rr < 2; ++rr) {
            const int row = 2 * grp + rr; float val = rr ? r1 : r0;
            if (MODE == 0) { val += bias16[nmap]; }
            else {
                float m = val;
#pragma unroll
                for (int o = 4; o < 64; o <<= 1) m = fmaxf(m, shx(m, o, lane));
                const float e = expf(val - m); float s = e;
#pragma unroll
                for (int o = 4; o < 64; o <<= 1) s += shx(s, o, lane);
                val = e / s;
            }
            if ((lane & 3) == 0) out16[(size_t)row * 16 + nmap] = val;
        }
    }
}

DI void attn_unit(Frame& F, int unit, const bf16_t* PROJ, const float* ropec, const float* ropes, const float* qg, const float* kg, const float* sinkp, bf16_t* MIX) {
    constexpr int KROW = 272;
    LAS unsigned char* KI = F.lds;
    LAS unsigned char* VT = F.lds + 128 * KROW;
    const int pair = unit & 1, kvh = (unit >> 1) & 1, qblk = (unit >> 2) & 15, b = unit >> 6;
    const int w = F.wave, lane = F.lane, r = lane & 31, hh = lane >> 5;
    const int head = kvh * 4 + pair * 2 + (w >> 2);
    const int tq0 = qblk * 128 + (w & 3) * 32, tq = tq0 + r;
    constexpr float QS = 0.08838834764831845f * LOG2E;
    bf16x8 qf[8];
    {
        const bf16_t* qrow = PROJ + (size_t)(b * SEQ + tq) * INWG + C_AQ + head * 128 + 8 * hh;
        float x[8][8]; float ss = 0.f;
#pragma unroll
        for (int k = 0; k < 8; ++k) { unpack8(*(const u32x4*)(qrow + 16 * k), x[k]);
#pragma unroll
            for (int j = 0; j < 8; ++j) ss += x[k][j] * x[k][j]; }
        ss += shx(ss, 32, lane);
        const float rstd = 1.0f / sqrtf(ss * (1.0f / 128.0f) + EPS);
#pragma unroll
        for (int k = 0; k < 8; ++k) { asm volatile("" ::: "memory");
            const f32x4 g0 = *(const f32x4*)(qg + 16 * k + 8 * hh), g1 = *(const f32x4*)(qg + 16 * k + 8 * hh + 4);
#pragma unroll
            for (int j = 0; j < 4; ++j) { x[k][j] *= rstd * g0[j]; x[k][4 + j] *= rstd * g1[j]; } }
#pragma unroll
        for (int k = 0; k < 4; ++k) { asm volatile("" ::: "memory");
            const float* cp = ropec + (size_t)tq * 64 + 16 * k + 8 * hh; const float* sp = ropes + (size_t)tq * 64 + 16 * k + 8 * hh;
            const f32x4 c0 = *(const f32x4*)cp, c1 = *(const f32x4*)(cp + 4), s0 = *(const f32x4*)sp, s1 = *(const f32x4*)(sp + 4);
            float lo[8], hi[8];
#pragma unroll
            for (int j = 0; j < 8; ++j) { const float cc = j < 4 ? c0[j] : c1[j - 4], sn = j < 4 ? s0[j] : s1[j - 4];
                lo[j] = (x[k][j] * cc - x[k + 4][j] * sn) * QS; hi[j] = (x[k + 4][j] * cc + x[k][j] * sn) * QS; }
            qf[k] = __builtin_bit_cast(bf16x8, pack8(lo)); qf[k + 4] = __builtin_bit_cast(bf16x8, pack8(hi));
        }
        asm volatile("" ::: "memory");
    }
    float m_run = sinkp[head] * LOG2E, l_run = 1.0f;
    f32x16 oacc[4];
#pragma unroll
    for (int i = 0; i < 4; ++i)
#pragma unroll
        for (int j = 0; j < 16; ++j) oacc[i][j] = 0.f;
    for (int kbi = -1; kbi <= 1; ++kbi) {
        const int kb = qblk + kbi;
        if (kb < 0 || kb >= SEQ / 128) continue;
        __syncthreads();
        u32x4 kraw[4], vraw[4];
#pragma unroll
        for (int i = 0; i < 4; ++i) { const int task = F.tid + NTHR * i, s = task >> 4, c = task & 15;
            const bf16_t* prow = PROJ + (size_t)(b * SEQ + kb * 128 + s) * INWG;
            kraw[i] = *(const u32x4*)(prow + C_AK + kvh * 128 + 8 * c); vraw[i] = *(const u32x4*)(prow + C_AV + kvh * 128 + 8 * c); }
#pragma unroll
        for (int i = 0; i < 4; ++i) {
            asm volatile("" ::: "memory");
            const int task = F.tid + NTHR * i, s = task >> 4, c = task & 15, pos = kb * 128 + s;
            float x[8], pr[8], o[8]; unpack8(kraw[i], x);
            float ss = 0.f;
#pragma unroll
            for (int j = 0; j < 8; ++j) ss += x[j] * x[j];
            ss += shx(ss, 1, lane); ss += shx(ss, 2, lane); ss += shx(ss, 4, lane); ss += shx(ss, 8, lane);
            const float rstd = 1.0f / sqrtf(ss * (1.0f / 128.0f) + EPS);
            const f32x4 g0 = *(const f32x4*)(kg + 8 * c), g1 = *(const f32x4*)(kg + 8 * c + 4);
#pragma unroll
            for (int j = 0; j < 8; ++j) x[j] *= rstd * (j < 4 ? g0[j] : g1[j - 4]);
#pragma unroll
            for (int j = 0; j < 8; ++j) pr[j] = shx(x[j], 8, lane);
            const float* cp = ropec + (size_t)pos * 64 + 8 * (c & 7); const float* sp = ropes + (size_t)pos * 64 + 8 * (c & 7);
            const f32x4 c0 = *(const f32x4*)cp, c1 = *(const f32x4*)(cp + 4), s0 = *(const f32x4*)sp, s1 = *(const f32x4*)(sp + 4);
#pragma unroll
            for (int j = 0; j < 8; ++j) { const float cc = j < 4 ? c0[j] : c1[j - 4], sn = j < 4 ? s0[j] : s1[j - 4];
                o[j] = (c < 8) ? (x[j] * cc - pr[j] * sn) : (x[j] * cc + pr[j] * sn); }
            *(LAS u32x4*)(KI + s * KROW + 16 * c) = pack8(o);
#pragma unroll
            for (int j = 0; j < 8; ++j) { const unsigned short hv = (unsigned short)((j & 1) ? (vraw[i][j >> 1] >> 16) : (vraw[i][j >> 1] & 0xffffu));
                *(LAS unsigned short*)(VT + (8 * c + j) * KROW + 2 * s) = hv; }
        }
        __syncthreads();
#pragma unroll 1
        for (int sub = 0; sub < 2; ++sub) {
            const int kpos0 = kb * 128 + sub * 64;
            if (kpos0 > tq0 + 31 + 128 || kpos0 + 63 < tq0 - 128) continue;
            f32x16 st[2];
#pragma unroll
            for (int kt = 0; kt < 2; ++kt) { asm volatile("" ::: "memory");
#pragma unroll
                for (int j = 0; j < 16; ++j) st[kt][j] = 0.f;
#pragma unroll
                for (int ks = 0; ks < 8; ++ks) { const bf16x8 a = *(const LAS bf16x8*)(KI + (sub * 64 + kt * 32 + r) * KROW + (16 * ks + 8 * hh) * 2);
                    st[kt] = MFMA32(a, qf[ks], st[kt]); }
            }
            float mx = -INFINITY;
#pragma unroll
            for (int kt = 0; kt < 2; ++kt)
#pragma unroll
                for (int rg = 0; rg < 16; ++rg) { const int kp = kpos0 + kt * 32 + (rg & 3) + 8 * (rg >> 2) + 4 * hh, dl = kp - tq;
                    const float sv = (dl <= 128 && dl >= -128) ? st[kt][rg] : -INFINITY; st[kt][rg] = sv; mx = fmaxf(mx, sv); }
            mx = fmaxf(mx, shx(mx, 32, lane));
            const float m_new = fmaxf(m_run, mx), alpha = fast_exp2(m_run - m_new);
            float rs = 0.f;
#pragma unroll
            for (int kt = 0; kt < 2; ++kt)
#pragma unroll
                for (int rg = 0; rg < 16; ++rg) { const float p = fast_exp2(st[kt][rg] - m_new); st[kt][rg] = p; rs += p; }
            rs += shx(rs, 32, lane);
            l_run = l_run * alpha + rs; m_run = m_new;
#pragma unroll
            for (int i = 0; i < 4; ++i)
#pragma unroll
                for (int j = 0; j < 16; ++j) oacc[i][j] *= alpha;
            bf16x8 pf[2][2];
#pragma unroll
            for (int kt = 0; kt < 2; ++kt)
#pragma unroll
                for (int s2 = 0; s2 < 2; ++s2) { float t8[8];
#pragma unroll
                    for (int j = 0; j < 8; ++j) t8[j] = st[kt][8 * s2 + j];
                    pf[kt][s2] = __builtin_bit_cast(bf16x8, pack8(t8)); }
#pragma unroll
            for (int dvt = 0; dvt < 4; ++dvt) { asm volatile("" ::: "memory");
#pragma unroll
                for (int kt = 0; kt < 2; ++kt)
#pragma unroll
                    for (int s2 = 0; s2 < 2; ++s2) { const int sb = sub * 64 + kt * 32 + 16 * s2;
                        const LAS unsigned char* vp = VT + (dvt * 32 + r) * KROW + (sb + 4 * hh) * 2;
                        const s16x4 lo = *(const LAS s16x4*)vp, hi = *(const LAS s16x4*)(vp + 16);
                        const bf16x8 a = __builtin_shufflevector(lo, hi, 0, 1, 2, 3, 4, 5, 6, 7);
                        oacc[dvt] = MFMA32(a, pf[kt][s2], oacc[dvt]); } }
        }
    }
    const float inv = 1.0f / l_run;
    bf16_t* orow = MIX + (size_t)(b * SEQ + tq) * D + head * 128 + 4 * hh;
#pragma unroll
    for (int dvt = 0; dvt < 4; ++dvt)
#pragma unroll
        for (int i = 0; i < 4; ++i) { u32x2 o; o.x = pk2(oacc[dvt][4 * i] * inv, oacc[dvt][4 * i + 1] * inv); o.y = pk2(oacc[dvt][4 * i + 2] * inv, oacc[dvt][4 * i + 3] * inv);
            *(u32x2*)(orow + dvt * 32 + 8 * i) = o; }
}

DI float scan_add(float v, int lane) {
#pragma unroll
    for (int o = 1; o < 64; o <<= 1) { const float t = shup(v, o, lane); if (lane >= o) v += t; }
    return v;
}
DI float scan_max(float v, int lane) {
#pragma unroll
    for (int o = 1; o < 64; o <<= 1) { const float t = shup(v, o, lane); if (lane >= o) v = fmaxf(v, t); }
    return v;
}
DI void mlstm_unit(Frame& F, int unit, const bf16_t* PROJ, const float* GATES, float* HF, float* HB) {
    constexpr int QROW = 272, TROW = 144;
    constexpr int O_QI = 0, O_KI = 64 * QROW, O_KT = 2 * 64 * QROW, O_VT = O_KT + 128 * TROW, O_PI = O_VT + 128 * TROW, O_GI = O_PI + 64 * TROW, O_WS = O_GI + 512;
    constexpr float SC = 0.08838834764831845f;
    LAS unsigned char* L = F.lds;
    const int dvh = unit & 1, dir = (unit >> 1) & 1, hd = (unit >> 2) & 3, b = unit >> 4;
    const int w = F.wave, lane = F.lane, l15 = lane & 15, kq = lane >> 4, tid = F.tid;
    LAS float* wsf = (LAS float*)(L + O_WS + w * 2048);
    LAS float* a_s = wsf; LAS float* mm_s = wsf + 64; LAS float* ei_s = wsf + 128; LAS float* wk_s = wsf + 192; LAS float* emt_s = wsf + 256; LAS float* invd_s = wsf + 320; LAS float* np_s = wsf + 384;
    float* HO = dir ? HB : HF;
    const int c0 = w * 16;
    f32x4 Cacc[8];
#pragma unroll
    for (int i = 0; i < 8; ++i) Cacc[i] = (f32x4){0.f, 0.f, 0.f, 0.f};
    float n0 = 0.f, n1 = 0.f, m_prev = 0.f;
    np_s[2 * lane] = 0.f; np_s[2 * lane + 1] = 0.f;
    u32x4 pq[2], pk[2], pv[2]; float pgi = 0.f, pgf = 0.f;
#define ML_LOAD(ch) do { _Pragma("unroll") for (int i = 0; i < 2; ++i) { const int task = tid + NTHR * i, s = task >> 4, c = task & 15; \
        const int p = (ch) * 64 + s, tok = dir ? (SEQ - 1 - p) : p; const bf16_t* prow = PROJ + (size_t)(b * SEQ + tok) * INWG; \
        pq[i] = *(const u32x4*)(prow + C_MQ + hd * 128 + 8 * c); pk[i] = *(const u32x4*)(prow + C_MK + hd * 128 + 8 * c); pv[i] = *(const u32x4*)(prow + C_MV + hd * 256 + dvh * 128 + 8 * c); } \
        if (tid < 64) { const int p = (ch) * 64 + tid, tok = dir ? (SEQ - 1 - p) : p; const float* gp = GATES + (size_t)(b * SEQ + tok) * 16; \
            pgi = gp[(dir ? 1 : 0) * 4 + hd]; pgf = gp[(dir ? 3 : 2) * 4 + hd]; } } while (0)
#define ML_WRITE() do { _Pragma("unroll") for (int i = 0; i < 2; ++i) { const int task = tid + NTHR * i, s = task >> 4, c = task & 15; \
        *(LAS u32x4*)(L + O_QI + s * QROW + 16 * c) = pq[i]; *(LAS u32x4*)(L + O_KI + s * QROW + 16 * c) = pk[i]; \
        _Pragma("unroll") for (int j = 0; j < 8; ++j) { \
            const unsigned short kvv = (unsigned short)((j & 1) ? (pk[i][j >> 1] >> 16) : (pk[i][j >> 1] & 0xffffu)); \
            const unsigned short vvv = (unsigned short)((j & 1) ? (pv[i][j >> 1] >> 16) : (pv[i][j >> 1] & 0xffffu)); \
            *(LAS unsigned short*)(L + O_KT + (8 * c + j) * TROW + 2 * s) = kvv; *(LAS unsigned short*)(L + O_VT + (8 * c + j) * TROW + 2 * s) = vvv; } } \
        if (tid < 64) { ((LAS float*)(L + O_GI))[tid] = pgi; ((LAS float*)(L + O_GI))[64 + tid] = pgf; } } while (0)
    __syncthreads();
    ML_LOAD(0);
    ML_WRITE();
    __syncthreads();
#pragma unroll 1
    for (int ch = 0; ch < SEQ / 64; ++ch) {
        if (ch + 1 < SEQ / 64) ML_LOAD(ch + 1);
        float aa;
        {
            const float ig = ((LAS float*)(L + O_GI))[lane], fg = ((LAS float*)(L + O_GI))[64 + lane];
            const float lf = fminf(fg, 0.f) - log1pf(expf(-fabsf(fg)));
            const float bcum = scan_add(lf, lane);
            const float a = ig - bcum;
            const float amax = scan_max(a, lane);
            const float btot = rdlane(bcum, 63), amax63 = rdlane(amax, 63);
            const float mm = fmaxf(amax, m_prev);
            const float m_loc = btot + amax63, m_new = fmaxf(btot + m_prev, m_loc);
            aa = expf(btot + m_prev - m_new);
            a_s[lane] = a; mm_s[lane] = mm; ei_s[lane] = expf(m_prev - mm) * SC; wk_s[lane] = expf(btot + a - m_new); emt_s[lane] = expf(-(bcum + mm));
            m_prev = m_new;
        }
#pragma unroll
        for (int u = 0; u < 2; ++u) {
            const int ti = w >> 1, si = 2 * (w & 1) + u;
            f32x4 acc = (f32x4){0.f, 0.f, 0.f, 0.f};
            if (si <= ti) {
#pragma unroll
                for (int ks = 0; ks < 4; ++ks) { const bf16x8 A = *(const LAS bf16x8*)(L + O_QI + (16 * ti + l15) * QROW + (32 * ks + 8 * kq) * 2);
                    const bf16x8 Bv = *(const LAS bf16x8*)(L + O_KI + (16 * si + l15) * QROW + (32 * ks + 8 * kq) * 2);
                    acc = MFMA16(A, Bv, acc); }
            }
            const int s = 16 * si + l15, t0 = 16 * ti + 4 * kq;
            const float as = a_s[s]; const f32x4 mmv = *(const LAS f32x4*)(mm_s + t0);
#pragma unroll
            for (int rg = 0; rg < 4; ++rg) { const int t = t0 + rg; const float dec = (s <= t) ? expf(as - mmv[rg]) * SC : 0.f;
                const float p = acc[rg] * dec; *(LAS unsigned short*)(L + O_PI + t * TROW + 2 * s) = (unsigned short)(pk2(p, 0.f) & 0xffffu); }
        }
        __syncthreads();
        bf16x8 vfr[2];
#pragma unroll
        for (int ks = 0; ks < 2; ++ks) vfr[ks] = *(const LAS bf16x8*)(L + O_VT + (c0 + l15) * TROW + (32 * ks + 8 * kq) * 2);
        bf16x8 cb[4];
#pragma unroll
        for (int ks = 0; ks < 4; ++ks) { u32x4 t; t.x = pk2(Cacc[2 * ks][0], Cacc[2 * ks][1]); t.y = pk2(Cacc[2 * ks][2], Cacc[2 * ks][3]); t.z = pk2(Cacc[2 * ks + 1][0], Cacc[2 * ks + 1][1]); t.w = pk2(Cacc[2 * ks + 1][2], Cacc[2 * ks + 1][3]);
            cb[ks] = __builtin_bit_cast(bf16x8, t); }
        f32x4 o1[4], o2[4];
#pragma unroll
        for (int mt = 0; mt < 4; ++mt) {
            o1[mt] = (f32x4){0.f, 0.f, 0.f, 0.f}; o2[mt] = (f32x4){0.f, 0.f, 0.f, 0.f};
#pragma unroll
            for (int ks = 0; ks < 2; ++ks) { const bf16x8 A = *(const LAS bf16x8*)(L + O_PI + (16 * mt + l15) * TROW + (32 * ks + 8 * kq) * 2); o1[mt] = MFMA16(A, vfr[ks], o1[mt]); }
#pragma unroll
            for (int ks = 0; ks < 4; ++ks) { const LAS unsigned char* qp = L + O_QI + (16 * mt + l15) * QROW + (32 * ks + 4 * kq) * 2;
                const s16x4 lo = *(const LAS s16x4*)qp, hi = *(const LAS s16x4*)(qp + 32);
                const bf16x8 A = __builtin_shufflevector(lo, hi, 0, 1, 2, 3, 4, 5, 6, 7); o2[mt] = MFMA16(A, cb[ks], o2[mt]); }
        }
        {
            float dsum = 0.f;
#pragma unroll
            for (int i = 0; i < 8; ++i) { float x8[8]; unpack8(*(const LAS u32x4*)(L + O_PI + lane * TROW + 16 * i), x8);
#pragma unroll
                for (int j = 0; j < 8; ++j) dsum += x8[j]; }
            float qn = 0.f;
#pragma unroll
            for (int i = 0; i < 16; ++i) { float x8[8]; unpack8(*(const LAS u32x4*)(L + O_QI + lane * QROW + 16 * i), x8);
                const f32x4 na = *(const LAS f32x4*)(np_s + 8 * i), nb = *(const LAS f32x4*)(np_s + 8 * i + 4);
                qn += (x8[0] * na[0] + x8[1] * na[1]) + (x8[2] * na[2] + x8[3] * na[3]) + (x8[4] * nb[0] + x8[5] * nb[1]) + (x8[6] * nb[2] + x8[7] * nb[3]); }
            const float den = dsum + ei_s[lane] * qn;
            invd_s[lane] = 1.0f / fmaxf(fabsf(den), emt_s[lane]);
        }
#pragma unroll
        for (int mt = 0; mt < 4; ++mt) { const int t0 = 16 * mt + 4 * kq;
            const f32x4 eiv = *(const LAS f32x4*)(ei_s + t0), idv = *(const LAS f32x4*)(invd_s + t0);
#pragma unroll
            for (int rg = 0; rg < 4; ++rg) { const int p = ch * 64 + t0 + rg, tok = dir ? (SEQ - 1 - p) : p;
                HO[(size_t)(b * SEQ + tok) * 1024 + hd * 256 + dvh * 128 + c0 + l15] = (o1[mt][rg] + eiv[rg] * o2[mt][rg]) * idv[rg]; } }
        {
            bf16x8 bw[2];
#pragma unroll
            for (int ks = 0; ks < 2; ++ks) { float x8[8]; unpack8(__builtin_bit_cast(u32x4, vfr[ks]), x8);
                const f32x4 wa = *(const LAS f32x4*)(wk_s + 32 * ks + 8 * kq), wb = *(const LAS f32x4*)(wk_s + 32 * ks + 8 * kq + 4);
#pragma unroll
                for (int j = 0; j < 4; ++j) { x8[j] *= wa[j]; x8[4 + j] *= wb[j]; }
                bw[ks] = __builtin_bit_cast(bf16x8, pack8(x8)); }
#pragma unroll
            for (int mt = 0; mt < 8; ++mt) { Cacc[mt] *= aa;
#pragma unroll
                for (int ks = 0; ks < 2; ++ks) { const bf16x8 A = *(const LAS bf16x8*)(L + O_KT + (16 * mt + l15) * TROW + (32 * ks + 8 * kq) * 2); Cacc[mt] = MFMA16(A, bw[ks], Cacc[mt]); } }
            float s0 = 0.f, s1 = 0.f;
#pragma unroll 8
            for (int s = 0; s < 64; ++s) { const unsigned kk = *(const LAS unsigned*)(L + O_KI + s * QROW + 4 * lane); const float wv = wk_s[s];
                s0 += wv * __uint_as_float(kk << 16); s1 += wv * __uint_as_float(kk & 0xffff0000u); }
            n0 = aa * n0 + s0; n1 = aa * n1 + s1;
            np_s[2 * lane] = n0; np_s[2 * lane + 1] = n1;
        }
        __syncthreads();
        if (ch + 1 < SEQ / 64) ML_WRITE();
        __syncthreads();
    }
#undef ML_LOAD
#undef ML_WRITE
}

DI void mout_phase(Frame& F, const float* HF, const float* HB, const bf16_t* PROJ, const float* m_gain, bf16_t* MIX) {
    const int gw = F.bid * NWAVES + F.wave, NGW = F.G * NWAVES, lane = F.lane;
    for (int row = gw; row < MTOK; row += NGW) {
#pragma unroll
        for (int j = 0; j < 4; ++j) { const int col = 256 * j + 4 * lane;
            const f32x4 v = *(const f32x4*)(HF + (size_t)row * 1024 + col) + *(const f32x4*)(HB + (size_t)row * 1024 + col);
            const float ss = wave_sum((v.x * v.x + v.y * v.y) + (v.z * v.z + v.w * v.w), lane);
            const float rstd = 1.0f / sqrtf(ss * (1.0f / 256.0f) + EPS);
            const f32x4 mg = *(const f32x4*)(m_gain + col);
            const u32x2 mo = *(const u32x2*)(PROJ + (size_t)row * INWG + C_MO + col);
            const float m0 = __uint_as_float(mo.x << 16), m1 = __uint_as_float(mo.x & 0xffff0000u), m2 = __uint_as_float(mo.y << 16), m3 = __uint_as_float(mo.y & 0xffff0000u);
            const float r0 = v.x * rstd * mg.x / (1.0f + expf(-m0)), r1 = v.y * rstd * mg.y / (1.0f + expf(-m1)), r2 = v.z * rstd * mg.z / (1.0f + expf(-m2)), r3 = v.w * rstd * mg.w / (1.0f + expf(-m3));
            u32x2 o; o.x = pk2(r0, r1); o.y = pk2(r2, r3);
            *(u32x2*)(MIX + (size_t)row * D + 1024 + col) = o; }
    }
}

DI void rank_phase(Frame& F, const float* AFF, int* SLOT, int* IDX, float* GATEV) {
    LAS float* vals = (LAS float*)F.lds;
    for (int task = F.bid; task < NB * NE * 4; task += F.G) {
        const int be = task >> 2, qtr = task & 3, b = be / NE, e = be % NE;
        __syncthreads();
        for (int i = F.tid; i < SEQ; i += NTHR) vals[i] = AFF[(size_t)(b * SEQ + i) * 16 + e];
        __syncthreads();
        const int t = qtr * 512 + F.tid; const float v = vals[t]; int cnt = 0;
#pragma unroll 4
        for (int j = 0; j < SEQ; j += 4) { const f32x4 q = *(const LAS f32x4*)(vals + j);
            cnt += (q.x > v || (q.x == v && j < t)) ? 1 : 0; cnt += (q.y > v || (q.y == v && j + 1 < t)) ? 1 : 0;
            cnt += (q.z > v || (q.z == v && j + 2 < t)) ? 1 : 0; cnt += (q.w > v || (q.w == v && j + 3 < t)) ? 1 : 0; }
        SLOT[(size_t)(b * SEQ + t) * 16 + e] = cnt < CAP ? cnt : -1;
        if (cnt < CAP) { IDX[be * CAP + cnt] = b * SEQ + t; GATEV[be * CAP + cnt] = v; }
    }
}

DI void combine_phase(Frame& F, const float* X1, const float* g2, const int* SLOT, const bf16_t* YE, float* OUT) {
    const int gw = F.bid * NWAVES + F.wave, NGW = F.G * NWAVES, lane = F.lane;
    for (int row = gw; row < MTOK; row += NGW) {
        const int b = row / SEQ;
        const int sl = SLOT[(size_t)row * 16 + (lane & 15)];
        float acc[4][8];
#pragma unroll
        for (int j = 0; j < 4; ++j)
#pragma unroll
            for (int i = 0; i < 8; ++i) acc[j][i] = 0.f;
        for (int e = 0; e < NE; ++e) { const int s = __builtin_amdgcn_readlane(sl, e);
            if (s >= 0) { const bf16_t* yr = YE + ((size_t)(b * NE + e) * CAP + s) * D + 8 * lane;
#pragma unroll
                for (int j = 0; j < 4; ++j) { float x8[8]; unpack8(*(const u32x4*)(yr + 512 * j), x8);
#pragma unroll
                    for (int i = 0; i < 8; ++i) acc[j][i] += x8[i]; } } }
#pragma unroll
        for (int j = 0; j < 4; ++j) { const int col = 512 * j + 8 * lane;
#pragma unroll
            for (int hlf = 0; hlf < 2; ++hlf) { const f32x4 xv = *(const f32x4*)(X1 + (size_t)row * D + col + 4 * hlf), gv = *(const f32x4*)(g2 + (size_t)b * 6 * D + col + 4 * hlf);
                f32x4 o; o.x = xv.x + gv.x * acc[j][4 * hlf]; o.y = xv.y + gv.y * acc[j][4 * hlf + 1]; o.z = xv.z + gv.z * acc[j][4 * hlf + 2]; o.w = xv.w + gv.w * acc[j][4 * hlf + 3];
                *(f32x4*)(OUT + (size_t)row * D + col + 4 * hlf) = o; } }
    }
}

struct Args { const float* in[15]; float* out; unsigned char* ws; int ph_lo, ph_hi; };
constexpr int N_PHASES = 1 + 10 * DEPTH;
typedef const __attribute__((address_space(4))) Args* KArgs;
#ifndef PH_MASK
#define PH_MASK 0x7FF
#endif
#define PHASE_ENV() KArgs ap = (KArgs)__builtin_amdgcn_kernarg_segment_ptr(); asm volatile("" : "+s"(ap)); unsigned char* const ws = ap->ws; (void)ws; \
    Frame F = F0; { int t_ = F0.tid; asm volatile("" : "+v"(t_)); F.tid = t_; F.lane = t_ & 63; F.wave = __builtin_amdgcn_readfirstlane(t_ >> 6); }

__global__ void __launch_bounds__(NTHR, 2) hymba_fwd(Args args) {
    extern __shared__ __attribute__((aligned(16))) unsigned char lds_raw[];
    Frame F0; F0.lds = (LAS unsigned char*)lds_raw; F0.tid = threadIdx.x; F0.lane = F0.tid & 63; F0.wave = __builtin_amdgcn_readfirstlane(F0.tid >> 6); F0.G = gridDim.x; F0.bid = blockIdx.x;
    const int lo = args.ph_lo, hi = args.ph_hi;
    volatile LAS unsigned* misc = (volatile LAS unsigned*)(F0.lds + LDS_MISC);
    if (F0.tid < 4) misc[F0.tid] = 0u;
    __syncthreads();
    XcdBarrier bar; bar.bar = (unsigned*)(args.ws + WS_CTL); bar.x = 0; bar.st = misc;
    if (hi - lo > 1) bar = xcd_barrier_post((unsigned*)(args.ws + WS_CTL), misc);
#define PHK(k) ((k) == 0 ? 0 : (((k) - 1) % 10) + 1)
#define IN(k) (((PH_MASK >> PHK(k)) & 1) && lo <= (k) && (k) < hi)
#define SEAM(k) do { if ((k) + 1 < hi) xcd_barrier(bar); } while (0)

    if (IN(0)) {
        PHASE_ENV();
        Ptrs P; P.x = ap->in[0]; P.c = ap->in[1]; P.w_ada = ap->in[2]; P.b_ada = ap->in[3]; P.w_in = ap->in[4]; P.b_gates = ap->in[5]; P.q_gain = ap->in[6]; P.k_gain = ap->in[7];
        P.sink = ap->in[8]; P.m_gain = ap->in[9]; P.w_out = ap->in[10]; P.w_router = ap->in[11]; P.w_gate = ap->in[12]; P.w_up = ap->in[13]; P.w_down = ap->in[14]; P.out = ap->out; P.ws = ws;
        p0_prologue(F, P); SEAM(0);
    }

#pragma unroll 1
    for (int l = 0; l < DEPTH; ++l) {
        const int pb = 1 + 10 * l;
        if (IN(pb + 0)) { PHASE_ENV();
            const float* xin = (l == 0) ? ap->in[0] : (const float*)(ws + WS_X2);
            const float* MOD = (const float*)(ws + WS_MOD) + (size_t)l * NB * 6 * D;
            norm_phase<0>(F, xin, MOD + 0 * D, MOD + 1 * D, ap->in[4] + (size_t)l * D * INW + C_MG, INW, ap->in[5] + l * 16, (bf16_t*)(ws + WS_H), (float*)(ws + WS_GATES)); SEAM(pb + 0); }
        if (IN(pb + 1)) { PHASE_ENV();
            pg8::SchedPlain<D> S{(const bf16_t*)(ws + WS_H), (const bf16_t*)(ws + WS_WIN) + (size_t)l * INWG * D, MTOK / 256, INWG / 256, F.G, F.bid}; pg8::EpiStoreBf16 E{(bf16_t*)(ws + WS_PROJ), INWG};
            pg8::gemm_phase<D>(F.lds, F.tid, S, E); SEAM(pb + 1); }
        if (IN(pb + 2)) {
            constexpr int NML = 64, NAT = 256;
#ifndef NO_ML
            if (F0.bid < NML) { PHASE_ENV(); mlstm_unit(F, F.bid, (const bf16_t*)(ws + WS_PROJ), (const float*)(ws + WS_GATES), (float*)(ws + WS_HF), (float*)(ws + WS_HB)); }
#endif
#ifndef NO_AT
            if (F0.bid >= NML) { PHASE_ENV();
#pragma unroll 1
                for (int u = F.bid - NML; u < NAT; u += F.G - NML) { Frame Fu = F; { int t_ = F.tid; asm volatile("" : "+v"(t_)); Fu.tid = t_; Fu.lane = t_ & 63; Fu.wave = __builtin_amdgcn_readfirstlane(t_ >> 6); }
                    attn_unit(Fu, u, (const bf16_t*)(ws + WS_PROJ), (const float*)(ws + WS_ROPEC), (const float*)(ws + WS_ROPES), ap->in[6] + l * 128, ap->in[7] + l * 128, ap->in[8] + l * 8, (bf16_t*)(ws + WS_MIX)); } }
#endif
            SEAM(pb + 2);
        }
        if (IN(pb + 3)) { PHASE_ENV(); mout_phase(F, (const float*)(ws + WS_HF), (const float*)(ws + WS_HB), (const bf16_t*)(ws + WS_PROJ), ap->in[9] + l * 1024, (bf16_t*)(ws + WS_MIX)); SEAM(pb + 3); }
        if (IN(pb + 4)) { PHASE_ENV();
            const float* xin = (l == 0) ? ap->in[0] : (const float*)(ws + WS_X2);
            const float* MOD = (const float*)(ws + WS_MOD) + (size_t)l * NB * 6 * D;
            pg8::SchedPlain<D> S{(const bf16_t*)(ws + WS_MIX), (const bf16_t*)(ws + WS_WOUT) + (size_t)l * D * D, MTOK / 256, D / 256, F.G, F.bid}; pg8::EpiResidual E{xin, (float*)(ws + WS_X1), MOD + 2 * D};
            pg8::gemm_phase<D>(F.lds, F.tid, S, E); SEAM(pb + 4); }
        if (IN(pb + 5)) { PHASE_ENV();
            const float* MOD = (const float*)(ws + WS_MOD) + (size_t)l * NB * 6 * D;
            norm_phase<1>(F, (const float*)(ws + WS_X1), MOD + 3 * D, MOD + 4 * D, ap->in[11] + (size_t)l * D * NE, NE, nullptr, (bf16_t*)(ws + WS_H), (float*)(ws + WS_AFF)); SEAM(pb + 5); }
        if (IN(pb + 6)) { PHASE_ENV(); rank_phase(F, (const float*)(ws + WS_AFF), (int*)(ws + WS_SLOT), (int*)(ws + WS_IDX), (float*)(ws + WS_GATEV)); SEAM(pb + 6); }
        if (IN(pb + 7)) { PHASE_ENV();
            LAS int* tbl = (LAS int*)(F.lds + LDS_TBL); const int* IDX = (const int*)(ws + WS_IDX);
            { pg8::Unit u; for (int i = 0; i < 8 && pg8::moe_unit(F.G, F.bid, i, u); ++i) for (int r = F.tid; r < 256; r += NTHR) tbl[i * 256 + r] = IDX[u.pm * CAP + r]; }
            __syncthreads();
            pg8::SchedMoeUp S{(const bf16_t*)(ws + WS_H), (const bf16_t*)(ws + WS_WGU) + (size_t)l * NE * 2 * FF * D, tbl, F.G, F.bid}; pg8::EpiSwiGLU E{(bf16_t*)(ws + WS_HID)};
            pg8::gemm_phase<D>(F.lds, F.tid, S, E); SEAM(pb + 7); }
        if (IN(pb + 8)) { PHASE_ENV();
            pg8::SchedMoeDown S{(const bf16_t*)(ws + WS_HID), (const bf16_t*)(ws + WS_WD) + (size_t)l * NE * D * FF, F.G, F.bid}; pg8::EpiGated E{(bf16_t*)(ws + WS_YE), (const float*)(ws + WS_GATEV)};
            pg8::gemm_phase<FF>(F.lds, F.tid, S, E); SEAM(pb + 8); }
        if (IN(pb + 9)) { PHASE_ENV();
            float* xout = (l == DEPTH - 1) ? ap->out : (float*)(ws + WS_X2);
            const float* MOD = (const float*)(ws + WS_MOD) + (size_t)l * NB * 6 * D;
            combine_phase(F, (const float*)(ws + WS_X1), MOD + 5 * D, (const int*)(ws + WS_SLOT), (const bf16_t*)(ws + WS_YE), xout); SEAM(pb + 9); }
    }
#undef IN
#undef SEAM
}

extern "C" void kernel_launch(void* const* d_in, const int* in_sizes, int n_in, void* d_out, int out_size, void* d_ws, size_t ws_size, hipStream_t stream) {
    static int grid = 0;
    if (grid == 0) {
        if (n_in != 15 || out_size != MTOK * D || ws_size < WS_END) { fprintf(stderr, "kernel_launch: unexpected shapes (n_in %d out %d ws %zu need %zu)\n", n_in, out_size, ws_size, (size_t)WS_END); grid = -1; return; }
        int dev = 0, cus = 0, per_cu = 0;
        if (hipGetDevice(&dev) != hipSuccess || hipDeviceGetAttribute(&cus, hipDeviceAttributeMultiprocessorCount, dev) != hipSuccess) { grid = -1; return; }
        if (hipFuncSetAttribute((const void*)hymba_fwd, hipFuncAttributeMaxDynamicSharedMemorySize, LDS_BYTES) != hipSuccess) { fprintf(stderr, "kernel_launch: hipFuncSetAttribute failed\n"); grid = -1; return; }
        if (hipOccupancyMaxActiveBlocksPerMultiprocessor(&per_cu, (const void*)hymba_fwd, NTHR, LDS_BYTES) != hipSuccess || per_cu < 1)
            fprintf(stderr, "kernel_launch: occupancy query reports %d workgroups per CU\n", per_cu);
        (void)hipGetLastError();
        grid = cus;
    }
    if (grid < 0) return;
    if (hipMemsetAsync((char*)d_ws + WS_CTL, 0, WS_ZERO_END, stream) != hipSuccess) { fprintf(stderr, "kernel_launch: memset failed\n"); return; }
    Args a{};
    for (int i = 0; i < 15; ++i) a.in[i] = (const float*)d_in[i];
    a.out = (float*)d_out; a.ws = (unsigned char*)d_ws;
#if MK_SPLIT
    for (int p = 0; p < N_PHASES; ++p) { a.ph_lo = p; a.ph_hi = p + 1; hipLaunchKernelGGL(hymba_fwd, dim3(grid), dim3(NTHR), LDS_BYTES, stream, a); }
#else
    a.ph_lo = 0; a.ph_hi = N_PHASES; hipLaunchKernelGGL(hymba_fwd, dim3(grid), dim3(NTHR), LDS_BYTES, stream, a);
#endif
    const hipError_t le = hipPeekAtLastError();
    if (le != hipSuccess) fprintf(stderr, "kernel_launch: launch failed: %s\n", hipGetErrorName(le));
}
```

```cpp
#include <hip/hip_runtime.h>
#include <cstdio>
#include <cstdint>
#include <type_traits>

#ifndef MK_SPLIT
#define MK_SPLIT 0
#endif
#define REP_ML 1
#define REP_AT 1
#define REP_MLS 1
#define REP_ML1 1
#define REP_ML2 1
#define IN8 0

#define LAS __attribute__((address_space(3)))
#define DI __device__ __forceinline__
typedef unsigned short bf16_t;
typedef short bf16x8 __attribute__((ext_vector_type(8)));
typedef short s16x4 __attribute__((ext_vector_type(4)));
typedef float f32x2 __attribute__((ext_vector_type(2)));
typedef float f32x4 __attribute__((ext_vector_type(4)));
typedef float f32x16 __attribute__((ext_vector_type(16)));
typedef unsigned u32x2 __attribute__((ext_vector_type(2)));
typedef unsigned u32x4 __attribute__((ext_vector_type(4)));
typedef __bf16 bfv2 __attribute__((ext_vector_type(2)));

constexpr int D = 2048, NB = 4, SEQ = 2048, MTOK = NB * SEQ, DEPTH = 2;
constexpr int INW = 4624, INWG = 4608, INWA = 3584;
constexpr int C_AQ = 0, C_AK = 1024, C_AV = 1280, C_MQ = 1536, C_MK = 2048, C_MV = 2560, C_MO = 3584, C_MG = 4608;
constexpr int NE = 16, FF = 1024, CAP = 256;
constexpr float EPS = 1e-6f;
constexpr int NWAVES = 8, NTHR = 512;

constexpr size_t al256(size_t x) { return (x + 255) & ~(size_t)255; }
constexpr size_t WS_CTL = 0;
constexpr size_t WS_MOD = 65536;
constexpr size_t MOD_BYTES = (size_t)DEPTH * NB * 6 * D * 4;
constexpr size_t WS_ZERO_END = 32768;
constexpr size_t WS_MOD_END = al256(WS_MOD + MOD_BYTES);
constexpr size_t WS_ROPEC = WS_MOD_END;
constexpr size_t WS_ROPES = WS_ROPEC + (size_t)SEQ * 64 * 4;
constexpr size_t WS_GATES = WS_ROPES + (size_t)SEQ * 64 * 4;
constexpr size_t WS_AFF = WS_GATES + (size_t)MTOK * 16 * 4;
constexpr size_t WS_SLOT = WS_AFF + (size_t)MTOK * 16 * 4;
constexpr size_t WS_IDX = WS_SLOT + (size_t)MTOK * 16 * 4;
constexpr size_t WS_GATEV = WS_IDX + (size_t)NB * NE * CAP * 4;
constexpr size_t WS_WIN = WS_GATEV + (size_t)NB * NE * CAP * 4;
constexpr size_t WS_WOUT = WS_WIN + (size_t)DEPTH * INWG * D * 2;
constexpr size_t WS_WGU = WS_WOUT + (size_t)DEPTH * D * D * 2;
constexpr size_t WS_WD = WS_WGU + (size_t)DEPTH * NE * 2 * FF * D * 2;
constexpr size_t WS_H = WS_WD + (size_t)DEPTH * NE * D * FF * 2;
constexpr size_t WS_PROJ = WS_H + (size_t)MTOK * D * 2;
constexpr size_t WS_MIX = WS_PROJ + (size_t)MTOK * INWG * 2;
constexpr size_t WS_HF = WS_MIX + (size_t)MTOK * D * 2;
constexpr size_t WS_HB = WS_HF + (size_t)MTOK * 1024 * 4;
constexpr size_t WS_X1 = WS_HB + (size_t)MTOK * 1024 * 4;
constexpr size_t WS_X2 = WS_X1 + (size_t)MTOK * D * 4;
constexpr size_t WS_HID = WS_X2 + (size_t)MTOK * D * 4;
constexpr size_t WS_YE = WS_HID + (size_t)NB * NE * CAP * FF * 2;
constexpr size_t WS_SCAL = WS_YE + (size_t)NB * NE * CAP * D * 2;
constexpr size_t WS_U = WS_SCAL + (size_t)2 * 3 * NB * 4 * SEQ * 4;
constexpr size_t WS_UN = WS_U + (size_t)32 * 8 * 128 * 256 * 4;
constexpr size_t WS_AA = WS_UN + (size_t)32 * 8 * 128 * 4;
constexpr size_t WS_CPREV = WS_AA + 4096;
constexpr size_t WS_NPREV = WS_CPREV + (size_t)32 * 7 * 128 * 256 * 2;
constexpr size_t WS_W16 = WS_NPREV + (size_t)32 * 7 * 128 * 4;
constexpr size_t WS_H8 = WS_W16 + (size_t)DEPTH * 2 * 16 * D * 2;
constexpr size_t WS_WMO8 = WS_H8 + (size_t)MTOK * D;
constexpr size_t WS_END = WS_WMO8 + (size_t)DEPTH * 1024 * D;

constexpr int LDS_STAGE = 131072;
constexpr int LDS_TBL = LDS_STAGE;
constexpr int LDS_MISC = LDS_STAGE + 8192;
constexpr int LDS_BYTES = LDS_STAGE + 8192 + 1024;

DI float bf2f(unsigned b16) { return __uint_as_float(b16 << 16); }
DI unsigned pk2(float lo, float hi) { bfv2 r = __builtin_convertvector((f32x2){lo, hi}, bfv2); return __builtin_bit_cast(unsigned, r); }
DI float shx(float v, int o, int lane) { return __int_as_float(__builtin_amdgcn_ds_bpermute((lane ^ o) << 2, __float_as_int(v))); }
DI float shup(float v, int o, int lane) { const int src = lane >= o ? lane - o : lane; return __int_as_float(__builtin_amdgcn_ds_bpermute(src << 2, __float_as_int(v))); }
DI u32x4 widen_pair(u32x2 a, u32x2 b) {
    const auto r0 = __builtin_amdgcn_permlane32_swap(a.x, b.x, false, false); const auto r1 = __builtin_amdgcn_permlane32_swap(a.y, b.y, false, false);
    return (u32x4){r0[0], r1[0], r0[1], r1[1]};
}
DI void narrow_pair(u32x4 w, u32x2& a, u32x2& b) {
    const auto r0 = __builtin_amdgcn_permlane32_swap(w.x, w.z, false, false); const auto r1 = __builtin_amdgcn_permlane32_swap(w.y, w.w, false, false);
    a = (u32x2){r0[0], r1[0]}; b = (u32x2){r0[1], r1[1]};
}
DI float rdlane(float v, int l) { return __int_as_float(__builtin_amdgcn_readlane(__float_as_int(v), l)); }
DI float wave_sum(float v, int lane) {
#pragma unroll
    for (int o = 1; o < 64; o <<= 1) v += shx(v, o, lane);
    return v;
}
DI void unpack8(const u32x4 raw, float (&x)[8]) {
#pragma unroll
    for (int i = 0; i < 4; ++i) { x[2 * i] = __uint_as_float(raw[i] << 16); x[2 * i + 1] = __uint_as_float(raw[i] & 0xffff0000u); }
}
DI u32x4 pack8(const float (&x)[8]) { u32x4 w; w.x = pk2(x[0], x[1]); w.y = pk2(x[2], x[3]); w.z = pk2(x[4], x[5]); w.w = pk2(x[6], x[7]); return w; }
DI float fast_exp2(float x) { return __builtin_amdgcn_exp2f(x); }
DI float fast_rcp(float x) { return __builtin_amdgcn_rcpf(x); }
#define LDS_WAIT() asm volatile("s_waitcnt lgkmcnt(0)" ::: "memory")
#define VM_WAIT() asm volatile("s_waitcnt vmcnt(0)" ::: "memory")
constexpr float LOG2E = 1.4426950408889634f;

#define XB_TMO      128
#define XB_XCNT(j)  (256  + 64 * (j))
#define XB_XSUB(j)  (1280 + 64 * (j))
#define XB_XGEN(j)  (2304 + 64 * (j))
#define XB_TOP      3328
#define XB_TOPGEN   3392
#define XCD_BAR_WORDS 3456
#define XB_SPIN_CAP (1u << 18)

DI unsigned xb_ld(unsigned* p)              { return __hip_atomic_load(p, __ATOMIC_RELAXED, __HIP_MEMORY_SCOPE_AGENT); }
DI unsigned xb_add(unsigned* p, unsigned v) { return __hip_atomic_fetch_add(p, v, __ATOMIC_RELAXED, __HIP_MEMORY_SCOPE_AGENT); }
DI unsigned xb_xcc_id() { return (unsigned)__builtin_amdgcn_s_getreg((3 << 11) | 20) & 0xFu; }
#define XB_SPIN(cond, bar) do { unsigned _sp = 0; while (cond) { __builtin_amdgcn_s_sleep(1); \
    if ((++_sp & 255u) == 0u) { if (xb_ld(&(bar)[XB_TMO])) break; if (_sp > XB_SPIN_CAP) { atomicAdd(&(bar)[XB_TMO], 1u); break; } } } } while (0)

struct XcdBarrier { unsigned* bar; unsigned x; volatile LAS unsigned* st; };

DI XcdBarrier xcd_barrier_post(unsigned* bar, volatile LAS unsigned* st) {
    XcdBarrier b; b.bar = bar; b.x = xb_xcc_id(); b.st = st;
    if (threadIdx.x == 0) (void)xb_add(&bar[XB_XCNT(b.x)], 1u);
    return b;
}
DI void xcd_barrier_complete(unsigned* bar, unsigned x, unsigned& nloc, unsigned& nx) {
    const unsigned G = gridDim.x * gridDim.y * gridDim.z;
    unsigned sum, cnt, sp = 0u;
    for (;;) {
        sum = 0u; cnt = 0u;
#pragma unroll 1
        for (unsigned j = 0; j < 16; ++j) { const unsigned c = xb_ld(&bar[XB_XCNT(j)]); sum += c; cnt += (c > 0u) ? 1u : 0u; }
        if (sum == G) break;
        __builtin_amdgcn_s_sleep(1);
        if ((++sp & 255u) == 0u) { if (xb_ld(&bar[XB_TMO])) break; if (sp > XB_SPIN_CAP) { atomicAdd(&bar[XB_TMO], 1u); break; } }
    }
    const unsigned mine = xb_ld(&bar[XB_XCNT(x)]);
    nloc = mine > 0u ? mine : 1u; nx = cnt > 0u ? cnt : 1u;
}
DI void xcd_barrier(const XcdBarrier& b) {
    asm volatile("s_waitcnt vmcnt(0)" ::: "memory");
    __syncthreads();
    if (threadIdx.x == 0) {
        unsigned* bar = b.bar; unsigned bx = b.x;
        asm volatile("" : "+s"(bar), "+s"(bx));
        __builtin_amdgcn_s_waitcnt(0);
        unsigned nloc = b.st[0], nx = b.st[1];
        if (nloc == 0u) { xcd_barrier_complete(bar, bx, nloc, nx); b.st[0] = nloc; b.st[1] = nx; }
        const unsigned old = xb_add(&bar[XB_XSUB(bx)], 1u);
        const unsigned gen = old / nloc;
        if (old + 1u == (gen + 1u) * nloc) {
            __builtin_amdgcn_fence(__ATOMIC_RELEASE, "agent");
            asm volatile("s_waitcnt vmcnt(0)" ::: "memory");
            const unsigned og = xb_add(&bar[XB_TOP], 1u);
            const unsigned tg = og / nx;
            if (og + 1u == (tg + 1u) * nx) xb_add(&bar[XB_TOPGEN], 1u);
            else XB_SPIN(xb_ld(&bar[XB_TOPGEN]) == tg, bar);
            __builtin_amdgcn_fence(__ATOMIC_ACQUIRE, "agent");
            xb_add(&bar[XB_XGEN(bx)], 1u);
            asm volatile("s_waitcnt vmcnt(0)" ::: "memory");
        } else {
            XB_SPIN(xb_ld(&bar[XB_XGEN(bx)]) == gen, bar);
            __builtin_amdgcn_fence(__ATOMIC_ACQUIRE, "agent");
            asm volatile("s_waitcnt vmcnt(0)" ::: "memory");
        }
    }
    __syncthreads();
}

namespace pg8 {
constexpr int BM = 256, BK = 64, HALF = 128, HTB = HALF * BK * 2, STAGE_BYTES = 8 * HTB, NXCD = 8, WGM = 8;
DI int lds_byte(int r, int c) { const int st = (r >> 4) * 2 + (c >> 5), rr = r & 15, cc = c & 31, ob = rr * 64 + cc * 2; return st * 1024 + (ob ^ (((ob >> 9) & 1) << 5)); }
DI void stage_rc(int b, int& R, int& C) { const int st = b / 1024, sb = b % 1024, swz = sb ^ (((sb >> 9) & 1) << 5); R = (st >> 1) * 16 + swz / 64; C = (st & 1) * 32 + (swz % 64) / 2; }
DI int perm32(int rho) { const int n = rho >> 4, i = rho & 15; return 8 * (i >> 2) + 4 * n + (i & 3); }
struct Unit { int pm, pn, aux; };

typedef int i32x8 __attribute__((ext_vector_type(8)));
typedef int i32x4v __attribute__((ext_vector_type(4)));
template <int KB, bool FP8, class Epi, class Sched>
DI void gemm_phase(LAS unsigned char* lds, const int tid, const Sched& S, const Epi& E) {
    const int wid = __builtin_amdgcn_readfirstlane(tid >> 6), lane = tid & 63, wr = wid >> 2, wc = wid & 3, fr = lane & 15, fq = lane >> 4;
    constexpr int nt = KB / 128;
    int R[2], C[2]; unsigned voffB[2];
#pragma unroll
    for (int i = 0; i < 2; ++i) { stage_rc(tid * 16 + i * 8192, R[i], C[i]); const int Rb = Epi::PERM ? ((R[i] & ~31) + perm32(R[i] & 31)) : R[i]; voffB[i] = (unsigned)(Rb * KB) + (unsigned)C[i] * 2u; }
    constexpr size_t kstep = (size_t)(BK * 2);
    constexpr size_t hstep = (size_t)HALF * KB;
    const unsigned ldsw = (unsigned)wid * 1024u;
    const int aoff = lds_byte(wr * 64 + fr, fq * 8), boff = lds_byte(wc * 32 + fr, fq * 8);
#define PG8_SA(b, h) (((b) * 2 + (h)) * HTB)
#define PG8_SB(b, h) ((4 + (b) * 2 + (h)) * HTB)
#define PG8_STAGE(bufoff, gbase, voff) do { _Pragma("unroll") for (int _i = 0; _i < 2; ++_i) \
        __builtin_amdgcn_global_load_lds((const unsigned*)((const char*)(gbase) + (voff)[_i]), (LAS unsigned*)(lds + (bufoff) + ldsw + _i * 8192), 16, 0, 0); } while (0)
#define PG8_LDA(dst, b, h) do { _Pragma("unroll") for (int m = 0; m < 4; ++m) _Pragma("unroll") for (int k = 0; k < 2; ++k) dst[m][k] = *(const LAS bf16x8*)(lds + PG8_SA(b, h) + aoff + m * 2048 + k * 1024); } while (0)
#define PG8_LDB(dst, b, h) do { _Pragma("unroll") for (int n = 0; n < 2; ++n) _Pragma("unroll") for (int k = 0; k < 2; ++k) dst[n][k] = *(const LAS bf16x8*)(lds + PG8_SB(b, h) + boff + n * 2048 + k * 1024); } while (0)
#define PG8_MMA(ai, bj, At, Bt) do { if constexpr (Sched::PRIO) __builtin_amdgcn_s_setprio(1); _Pragma("unroll") for (int m = 0; m < 4; ++m) _Pragma("unroll") for (int n = 0; n < 2; ++n) { \
        if constexpr (FP8) { const i32x8 a8 = __builtin_shufflevector(__builtin_bit_cast(i32x4v, Bt[n][0]), __builtin_bit_cast(i32x4v, Bt[n][1]), 0, 1, 2, 3, 4, 5, 6, 7), \
                                         b8 = __builtin_shufflevector(__builtin_bit_cast(i32x4v, At[m][0]), __builtin_bit_cast(i32x4v, At[m][1]), 0, 1, 2, 3, 4, 5, 6, 7); \
            acc[ai][bj][m][n] = __builtin_amdgcn_mfma_scale_f32_16x16x128_f8f6f4(a8, b8, acc[ai][bj][m][n], 0, 0, 0, 0x7f7f7f7f, 0, 0x7f7f7f7f); } \
        else { _Pragma("unroll") for (int k = 0; k < 2; ++k) acc[ai][bj][m][n] = __builtin_amdgcn_mfma_f32_16x16x32_bf16(Bt[n][k], At[m][k], acc[ai][bj][m][n], 0, 0, 0); } } \
        if constexpr (Sched::PRIO) __builtin_amdgcn_s_setprio(0); } while (0)
#define PG8_WAIT_V(n) asm volatile("s_waitcnt vmcnt(" #n ")" ::: "memory")
#define PG8_WAIT_L(n) asm volatile("s_waitcnt lgkmcnt(" #n ")" ::: "memory")
#define PG8_BAR __builtin_amdgcn_s_barrier()
#define PG8_SCHED __builtin_amdgcn_sched_barrier(0)
    Unit cur, nxt; int ui = 0;
    if (!S.next(0, cur)) return;
    float z0_ = 0.f; asm volatile("" : "+v"(z0_));
    const f32x4 ZERO4 = (f32x4){z0_, z0_, z0_, z0_};
    f32x4 acc[2][2][4][2];
#pragma unroll
    for (int a = 0; a < 2; ++a)
#pragma unroll
        for (int b = 0; b < 2; ++b)
#pragma unroll
            for (int m = 0; m < 4; ++m)
#pragma unroll
                for (int n = 0; n < 2; ++n) acc[a][b][m][n] = ZERO4;
    bf16x8 At[4][2], B0[2][2], B1[2][2];
    unsigned vA0[2], vA1[2], vN0[2], vN1[2];
    S.a_off(cur, 0, R, C, vA0, vA1);
    const char* cA = S.a_ptr(cur); const char* cB = S.b_ptr(cur);
    PG8_STAGE(PG8_SB(0, 0), cB, voffB); PG8_STAGE(PG8_SA(0, 0), cA, vA0); PG8_STAGE(PG8_SB(0, 1), cB + hstep, voffB); PG8_STAGE(PG8_SA(0, 1), cA, vA1);
    if (wr == 1) PG8_BAR;
    PG8_WAIT_V(4); PG8_BAR;
    PG8_STAGE(PG8_SB(1, 0), cB + kstep, voffB); PG8_STAGE(PG8_SA(1, 0), cA + kstep, vA0); PG8_STAGE(PG8_SB(1, 1), cB + hstep + kstep, voffB);
    PG8_WAIT_V(6); PG8_BAR;
    for (;;) {
        const bool has_next = S.next(ui + 1, nxt);
        const char* nA = has_next ? S.a_ptr(nxt) : cA; const char* nB = has_next ? S.b_ptr(nxt) : cB;
        if constexpr (Sched::GATHER) { if (has_next) S.a_off(nxt, ui + 1, R, C, vN0, vN1); else { vN0[0] = vA0[0]; vN0[1] = vA0[1]; vN1[0] = vA1[0]; vN1[1] = vA1[1]; } }
#pragma unroll 1
        for (int t = 0; t < nt; t += 2) {
            const bool last = (t == nt - 2);
            const char* a1 = cA + (size_t)(t + 1) * kstep;
            const char* a2 = last ? nA : cA + (size_t)(t + 2) * kstep; const char* b2 = last ? nB : cB + (size_t)(t + 2) * kstep;
            const char* a3 = a2 + kstep; const char* b3 = b2 + kstep;
            PG8_LDB(B0, 0, 0); PG8_SCHED; PG8_LDA(At, 0, 0); PG8_STAGE(PG8_SA(1, 1), a1, vA1);
            if constexpr (Sched::GATHER) { if (last) { vA0[0] = vN0[0]; vA0[1] = vN0[1]; vA1[0] = vN1[0]; vA1[1] = vN1[1]; } }
            PG8_WAIT_L(8); PG8_BAR; PG8_WAIT_L(0); PG8_MMA(0, 0, At, B0); PG8_BAR; PG8_SCHED;
            PG8_LDB(B1, 0, 1); PG8_STAGE(PG8_SB(0, 0), b2, voffB);
            PG8_BAR; PG8_WAIT_L(0); PG8_MMA(0, 1, At, B1); PG8_BAR;
            PG8_LDA(At, 0, 1); PG8_STAGE(PG8_SA(0, 0), a2, vA0);
            PG8_BAR; PG8_WAIT_L(0); PG8_MMA(1, 0, At, B0); PG8_BAR; PG8_SCHED;
            PG8_STAGE(PG8_SB(0, 1), b2 + hstep, voffB);
            PG8_WAIT_V(6); PG8_BAR; PG8_MMA(1, 1, At, B1); PG8_BAR;
            PG8_LDB(B0, 1, 0); PG8_SCHED; PG8_LDA(At, 1, 0); PG8_STAGE(PG8_SA(0, 1), a2, vA1);
            PG8_WAIT_L(8); PG8_BAR; PG8_WAIT_L(0); PG8_MMA(0, 0, At, B0); PG8_BAR; PG8_SCHED;
            PG8_LDB(B1, 1, 1); PG8_STAGE(PG8_SB(1, 0), b3, voffB);
            PG8_BAR; PG8_WAIT_L(0); PG8_MMA(0, 1, At, B1); PG8_BAR;
            PG8_LDA(At, 1, 1); PG8_STAGE(PG8_SA(1, 0), a3, vA0);
            PG8_BAR; PG8_WAIT_L(0); PG8_MMA(1, 0, At, B0); PG8_BAR; PG8_SCHED;
            PG8_STAGE(PG8_SB(1, 1), b3 + hstep, voffB);
            PG8_WAIT_V(6); PG8_BAR; PG8_MMA(1, 1, At, B1); PG8_BAR;
        }
        E(acc, cur, wr, wc, fr, fq);
        if (!has_next) break;
#pragma unroll
        for (int a = 0; a < 2; ++a)
#pragma unroll
            for (int b = 0; b < 2; ++b)
#pragma unroll
                for (int m = 0; m < 4; ++m)
#pragma unroll
                    for (int n = 0; n < 2; ++n) acc[a][b][m][n] = ZERO4;
        cur = nxt; cA = nA; cB = nB; ++ui;
    }
    PG8_WAIT_V(0);
    if (wr == 0) PG8_BAR;
    PG8_BAR;
#undef PG8_SA
#undef PG8_SB
#undef PG8_STAGE
#undef PG8_LDA
#undef PG8_LDB
#undef PG8_MMA
#undef PG8_WAIT_V
#undef PG8_WAIT_L
#undef PG8_BAR
#undef PG8_SCHED
}

DI bool static_unit(int nM, int nN, int G, int c, int i, int& pm, int& pn) {
    const int nwg = nM * nN; const long L = (long)i * G + c; if (L >= nwg) return false;
    int wgid = (int)L; { const int q = nwg / NXCD, r = nwg % NXCD, xcd = wgid % NXCD, off = wgid / NXCD; wgid = (xcd < r ? xcd * (q + 1) : r * (q + 1) + (xcd - r) * q) + off; }
    const int nig = WGM * nN, gid = wgid / nig, fm = gid * WGM, gsz = (nM - fm) < WGM ? (nM - fm) : WGM;
    pm = fm + ((wgid % nig) % gsz); pn = (wgid % nig) / gsz; return true;
}
template <int KB, bool PRIO_ = true> struct SchedPlain {
    static constexpr bool GATHER = false, PRIO = PRIO_;
    const bf16_t* A; const bf16_t* Bt; int nM, nN, G, c;
    DI bool next(int i, Unit& u) const { u.aux = 0; return static_unit(nM, nN, G, c, i, u.pm, u.pn); }
    DI const char* a_ptr(const Unit& u) const { return (const char*)A + (size_t)u.pm * BM * KB; }
    DI const char* b_ptr(const Unit& u) const { return (const char*)Bt + (size_t)u.pn * BM * KB; }
    DI void a_off(const Unit&, int, const int (&R)[2], const int (&C)[2], unsigned (&v0)[2], unsigned (&v1)[2]) const {
#pragma unroll
        for (int i = 0; i < 2; ++i) { v0[i] = (unsigned)(R[i] * KB + C[i] * 2); v1[i] = (unsigned)((R[i] + HALF) * KB + C[i] * 2); }
    }
};
DI bool moe_unit(int G, int c, int i, Unit& u) {
    const int L = i * G + c; if (L >= NB * NE * 8) return false;
    const int wgid = (L % NXCD) * (NB * NE * 8 / NXCD) + L / NXCD;
    const int e = wgid >> 5, ntile = (wgid >> 2) & 7, b = wgid & 3;
    u.pm = b * NE + e; u.pn = ntile; u.aux = e; return true;
}
struct SchedMoeUp {
    static constexpr bool GATHER = true, PRIO = true;
    const unsigned char* Hm; const unsigned char* W; const LAS int* tbl; int G, c;
    DI bool next(int i, Unit& u) const { return moe_unit(G, c, i, u); }
    DI const char* a_ptr(const Unit&) const { return (const char*)Hm; }
    DI const char* b_ptr(const Unit& u) const { return (const char*)W + ((size_t)u.aux * 2 * FF + (size_t)u.pn * BM) * D; }
    DI void a_off(const Unit&, int i, const int (&R)[2], const int (&C)[2], unsigned (&v0)[2], unsigned (&v1)[2]) const {
#pragma unroll
        for (int j = 0; j < 2; ++j) { const int r0 = tbl[i * 256 + R[j]], r1 = tbl[i * 256 + HALF + R[j]];
            v0[j] = (unsigned)(r0 * D + C[j] * 2); v1[j] = (unsigned)(r1 * D + C[j] * 2); }
    }
};
struct SchedMoeDown {
    static constexpr bool GATHER = false, PRIO = false;
    const unsigned char* Hid; const unsigned char* W; int G, c;
    DI bool next(int i, Unit& u) const { return moe_unit(G, c, i, u); }
    DI const char* a_ptr(const Unit& u) const { return (const char*)Hid + (size_t)u.pm * BM * FF; }
    DI const char* b_ptr(const Unit& u) const { return (const char*)W + ((size_t)u.aux * D + (size_t)u.pn * BM) * FF; }
    DI void a_off(const Unit&, int, const int (&R)[2], const int (&C)[2], unsigned (&v0)[2], unsigned (&v1)[2]) const {
#pragma unroll
        for (int i = 0; i < 2; ++i) { v0[i] = (unsigned)(R[i] * FF + C[i] * 2); v1[i] = (unsigned)((R[i] + HALF) * FF + C[i] * 2); }
    }
};

DI unsigned pk4_fp8(float a, float b, float c, float d) { int p = 0; p = __builtin_amdgcn_cvt_pk_fp8_f32(a, b, p, false); p = __builtin_amdgcn_cvt_pk_fp8_f32(c, d, p, true); return (unsigned)p; }
constexpr float WSC_UP = 64.0f, WSC_DOWN = 32.0f;
DI unsigned cvt_pk_bf16(float lo, float hi) { unsigned r; asm volatile("v_cvt_pk_bf16_f32 %0, %1, %2" : "=v"(r) : "v"(lo), "v"(hi)); return r; }

struct EpiStoreBf16 {
    static constexpr bool PERM = true;
    bf16_t* O; int ldc; float scale;
    DI void operator()(const f32x4 (&acc)[2][2][4][2], const Unit& u, int wr, int wc, int fr, int fq) const {
        const int row0 = u.pm * BM + wr * 64 + fr, col0 = u.pn * BM + wc * 32 + 8 * fq;
#pragma unroll
        for (int ai = 0; ai < 2; ++ai)
#pragma unroll
            for (int m = 0; m < 4; ++m) { bf16_t* rowp = O + (size_t)(row0 + ai * HALF + m * 16) * ldc + col0;
#pragma unroll
                for (int bj = 0; bj < 2; ++bj) { const f32x4 v0 = acc[ai][bj][m][0] * scale, v1 = acc[ai][bj][m][1] * scale;
                    u32x4 w; w.x = cvt_pk_bf16(v0[0], v0[1]); w.y = cvt_pk_bf16(v0[2], v0[3]); w.z = cvt_pk_bf16(v1[0], v1[1]); w.w = cvt_pk_bf16(v1[2], v1[3]);
                    *(u32x4*)(rowp + bj * HALF) = w; } }
    }
};
template <bool XBF> struct EpiResidual {
    static constexpr bool PERM = true;
    const void* Xin; bf16_t* Out; const float* g;
    DI void operator()(const f32x4 (&acc)[2][2][4][2], const Unit& u, int wr, int wc, int fr, int fq) const {
        const int row0 = u.pm * BM + wr * 64 + fr, col0 = u.pn * BM + wc * 32 + 8 * fq;
        const float* gb = g + (size_t)(u.pm / (SEQ / BM)) * 6 * D + col0;
        f32x4 gv[2][2];
#pragma unroll
        for (int bj = 0; bj < 2; ++bj)
#pragma unroll
            for (int n = 0; n < 2; ++n) gv[bj][n] = *(const f32x4*)(gb + bj * HALF + n * 4);
#pragma unroll
        for (int ai = 0; ai < 2; ++ai)
#pragma unroll
            for (int m = 0; m < 4; ++m) { const size_t ro = (size_t)(row0 + ai * HALF + m * 16) * D + col0;
#pragma unroll
                for (int bj = 0; bj < 2; ++bj) { float x8[8];
                    if (XBF) unpack8(*(const u32x4*)((const bf16_t*)Xin + ro + bj * HALF), x8);
                    else { const f32x4 xa = *(const f32x4*)((const float*)Xin + ro + bj * HALF), xb = *(const f32x4*)((const float*)Xin + ro + bj * HALF + 4);
                        x8[0] = xa[0]; x8[1] = xa[1]; x8[2] = xa[2]; x8[3] = xa[3]; x8[4] = xb[0]; x8[5] = xb[1]; x8[6] = xb[2]; x8[7] = xb[3]; }
#pragma unroll
                    for (int n = 0; n < 2; ++n)
#pragma unroll
                        for (int j = 0; j < 4; ++j) x8[n * 4 + j] += gv[bj][n][j] * acc[ai][bj][m][n][j];
                    u32x4 w; w.x = cvt_pk_bf16(x8[0], x8[1]); w.y = cvt_pk_bf16(x8[2], x8[3]); w.z = cvt_pk_bf16(x8[4], x8[5]); w.w = cvt_pk_bf16(x8[6], x8[7]);
                    *(u32x4*)(Out + ro + bj * HALF) = w; } }
    }
};
struct EpiSwiGLU {
    static constexpr bool PERM = true;
    unsigned char* Hid;
    DI void operator()(const f32x4 (&acc)[2][2][4][2], const Unit& u, int wr, int wc, int fr, int fq) const {
        const int row0 = u.pm * BM + wr * 64 + fr, col0 = u.pn * HALF + wc * 32 + 8 * fq;
#pragma unroll
        for (int ai = 0; ai < 2; ++ai)
#pragma unroll
            for (int m = 0; m < 4; ++m) { unsigned char* rowp = Hid + (size_t)(row0 + ai * HALF + m * 16) * FF + col0;
                float h[8];
#pragma unroll
                for (int n = 0; n < 2; ++n)
#pragma unroll
                    for (int j = 0; j < 4; ++j) { const float gg = acc[ai][0][m][n][j] * (1.0f / WSC_UP), uu = acc[ai][1][m][n][j] * (1.0f / WSC_UP);
                        h[n * 4 + j] = gg * fast_rcp(1.0f + fast_exp2(-gg * LOG2E)) * uu; }
                u32x2 w; w.x = pk4_fp8(h[0], h[1], h[2], h[3]); w.y = pk4_fp8(h[4], h[5], h[6], h[7]);
                *(u32x2*)rowp = w; }
    }
};
struct EpiGated {
    static constexpr bool PERM = true;
    bf16_t* O; const float* gate;
    DI void operator()(const f32x4 (&acc)[2][2][4][2], const Unit& u, int wr, int wc, int fr, int fq) const {
        const int row0 = u.pm * BM + wr * 64 + fr, col0 = u.pn * BM + wc * 32 + 8 * fq;
#pragma unroll
        for (int ai = 0; ai < 2; ++ai)
#pragma unroll
            for (int m = 0; m < 4; ++m) { const int row = row0 + ai * HALF + m * 16; const float gt = gate[row] * (1.0f / WSC_DOWN); bf16_t* rowp = O + (size_t)row * D + col0;
#pragma unroll
                for (int bj = 0; bj < 2; ++bj) { const f32x4 v0 = acc[ai][bj][m][0] * gt, v1 = acc[ai][bj][m][1] * gt;
                    u32x4 w; w.x = cvt_pk_bf16(v0[0], v0[1]); w.y = cvt_pk_bf16(v0[2], v0[3]); w.z = cvt_pk_bf16(v1[0], v1[1]); w.w = cvt_pk_bf16(v1[2], v1[3]);
                    *(u32x4*)(rowp + bj * HALF) = w; } }
    }
};
}

struct Frame { LAS unsigned char* lds; int tid, lane, wave, G, bid; };
#define MFMA16(a, b, c) __builtin_amdgcn_mfma_f32_16x16x32_bf16((a), (b), (c), 0, 0, 0)
#define MFMA32(a, b, c) __builtin_amdgcn_mfma_f32_32x32x16_bf16((a), (b), (c), 0, 0, 0)


struct CvItem { const float* src; void* dst; int ldw, K, dst_row, k0, n0; float scale; bool fp8; };
DI void cv_load(const CvItem& it, f32x4 (&v)[16], int lane) {
    const float* src = it.src + (size_t)(it.k0 + (lane >> 3)) * it.ldw + it.n0 + 4 * (lane & 7);
#pragma unroll
    for (int i = 0; i < 16; ++i) v[i] = *(const f32x4*)(src + (size_t)(8 * i) * it.ldw);
}
DI void cv_store(const CvItem& it, const f32x4 (&v)[16], LAS float* scr, int lane) {
#pragma unroll
    for (int i = 0; i < 16; ++i) { LAS float* d = scr + (8 * i + (lane >> 3)) * 33 + 4 * (lane & 7); d[0] = v[i].x; d[1] = v[i].y; d[2] = v[i].z; d[3] = v[i].w; }
    LDS_WAIT();
    const int c = lane & 7; const float scale = it.scale;
#pragma unroll
    for (int j = 0; j < 4; ++j) { const int n = (lane >> 3) + 8 * j; const LAS float* s = scr + (16 * c) * 33 + n;
        float t[16];
#pragma unroll
        for (int i = 0; i < 16; ++i) t[i] = s[i * 33];
        if (it.fp8) { u32x4 o; o.x = pg8::pk4_fp8(t[0] * scale, t[1] * scale, t[2] * scale, t[3] * scale); o.y = pg8::pk4_fp8(t[4] * scale, t[5] * scale, t[6] * scale, t[7] * scale);
            o.z = pg8::pk4_fp8(t[8] * scale, t[9] * scale, t[10] * scale, t[11] * scale); o.w = pg8::pk4_fp8(t[12] * scale, t[13] * scale, t[14] * scale, t[15] * scale);
            *(u32x4*)((unsigned char*)it.dst + (size_t)(it.dst_row + n) * it.K + it.k0 + 16 * c) = o; }
        else { u32x4 o0, o1; o0.x = pk2(t[0], t[1]); o0.y = pk2(t[2], t[3]); o0.z = pk2(t[4], t[5]); o0.w = pk2(t[6], t[7]); o1.x = pk2(t[8], t[9]); o1.y = pk2(t[10], t[11]); o1.z = pk2(t[12], t[13]); o1.w = pk2(t[14], t[15]);
            bf16_t* d = (bf16_t*)it.dst + (size_t)(it.dst_row + n) * it.K + it.k0 + 16 * c; *(u32x4*)d = o0; *(u32x4*)(d + 8) = o1; } }
    LDS_WAIT();
}
struct Ptrs {
    const float *x, *c, *w_ada, *b_ada, *w_in, *b_gates, *q_gain, *k_gain, *sink, *m_gain, *w_out, *w_router, *w_gate, *w_up, *w_down;
    float* out; unsigned char* ws;
};
constexpr int CV_IN = (D / 128) * (INWG / 32), CV_OUT = (D / 128) * (D / 32), CV_GE = (D / 128) * (FF / 32), CV_G = NE * CV_GE, CV_DE = (FF / 128) * (D / 32), CV_D = NE * CV_DE;
constexpr int CV_PER_LAYER = CV_IN + CV_OUT + 2 * CV_G + CV_D, CV_TOTAL = DEPTH * CV_PER_LAYER;
constexpr int CV_DEFER = 0;
DI CvItem cv_decode(const Ptrs& P, int it) {
    unsigned char* ws = P.ws; CvItem c;
    const int l = it / CV_PER_LAYER; int r = it % CV_PER_LAYER;
    if (r < CV_IN) { const int kb = r / (INWG / 32), nb = r % (INWG / 32); c.src = P.w_in + (size_t)l * D * INW; c.ldw = INW; c.K = D; c.k0 = 128 * kb; c.n0 = 32 * nb;
        if (32 * nb < INWA) { c.dst = (bf16_t*)(ws + WS_WIN) + (size_t)l * INWG * D; c.dst_row = 32 * nb; c.scale = 1.0f; c.fp8 = false; }
        else { c.dst = (unsigned char*)(ws + WS_WMO8) + (size_t)l * 1024 * D; c.dst_row = 32 * nb - INWA; c.scale = pg8::WSC_UP; c.fp8 = true; }
        return c; }
    r -= CV_IN;
    if (r < CV_OUT) { const int kb = r / (D / 32), nb = r % (D / 32); c.src = P.w_out + (size_t)l * D * D; c.ldw = D; c.K = D; c.k0 = 128 * kb; c.n0 = 32 * nb;
        c.dst = (bf16_t*)(ws + WS_WOUT) + (size_t)l * D * D; c.dst_row = 32 * nb; c.scale = 1.0f; c.fp8 = false; return c; }
    r -= CV_OUT;
    if (r < 2 * CV_G) { const int up = r >= CV_G; if (up) r -= CV_G;
        const int e = r / CV_GE, q = r % CV_GE, kb = q / (FF / 32), nb = q % (FF / 32), n0 = 32 * nb;
        c.src = (up ? P.w_up : P.w_gate) + (size_t)(l * NE + e) * D * FF; c.ldw = FF; c.K = D; c.k0 = 128 * kb; c.n0 = n0;
        c.dst = (unsigned char*)(ws + WS_WGU) + (size_t)(l * NE + e) * 2 * FF * D; c.dst_row = (n0 / 128) * 256 + (n0 % 128) + (up ? 128 : 0); c.scale = pg8::WSC_UP; c.fp8 = true; return c; }
    r -= 2 * CV_G;
    { const int e = r / CV_DE, q = r % CV_DE, kb = q / (D / 32), nb = q % (D / 32);
        c.src = P.w_down + (size_t)(l * NE + e) * FF * D; c.ldw = D; c.K = FF; c.k0 = 128 * kb; c.n0 = 32 * nb;
        c.dst = (unsigned char*)(ws + WS_WD) + (size_t)(l * NE + e) * D * FF; c.dst_row = 32 * nb; c.scale = pg8::WSC_DOWN; c.fp8 = true; return c; }
}
DI void convert_range(Frame& F, const Ptrs& P, const int it_lo, const int it_hi, const int gw, const int NGW) {
    LAS float* scr = (LAS float*)(F.lds + F.wave * 16896);
    int it = it_lo + gw;
    if (it >= it_hi) return;
    f32x4 v[16];
    { const CvItem c0 = cv_decode(P, it); cv_load(c0, v, F.lane); }
#pragma unroll 1
    for (;;) {
        const int nx = it + NGW; const bool more = nx < it_hi;
        f32x4 w[16];
#pragma unroll
        for (int i = 0; i < 16; ++i) w[i] = v[i];
        if (more) { const CvItem cn = cv_decode(P, nx); cv_load(cn, v, F.lane); }
        { const CvItem cc = cv_decode(P, it); cv_store(cc, w, scr, F.lane); }
        if (!more) break;
        it = nx;
    }
}
DI void p0_prologue(Frame& F, const Ptrs& P, const bool do_mod) {
    unsigned char* ws = P.ws;
    convert_range(F, P, 0, CV_TOTAL - CV_DEFER, F.bid * NWAVES + F.wave, F.G * NWAVES);
    {
        bf16_t* w16 = (bf16_t*)(ws + WS_W16);
        for (int idx = F.bid * NTHR + F.tid; idx < DEPTH * 2 * 16 * D; idx += F.G * NTHR) {
            const int k = idx % D, n = (idx / D) % 16, m = (idx / (16 * D)) % 2, l = idx / (2 * 16 * D);
            const float v = m ? P.w_router[((size_t)l * D + k) * NE + n] : P.w_in[((size_t)l * D + k) * INW + C_MG + n];
            w16[idx] = (bf16_t)(pk2(v, 0.f) & 0xffffu);
        }
    }
    {
        float* rc = (float*)(ws + WS_ROPEC); float* rs = (float*)(ws + WS_ROPES);
        for (int idx = F.bid * NTHR + F.tid; idx < SEQ * 64; idx += F.G * NTHR) {
            const int pos = idx >> 6, j = idx & 63;
            const float pw = (float)exp(9.210340371976184 * ((double)j / 64.0));
            const float inv = 1.0f / pw;
            const float ang = (float)pos * inv;
            rc[idx] = (float)cos((double)ang); rs[idx] = (float)sin((double)ang);
        }
    }
    __syncthreads();
    if (do_mod) {
        LAS float* cact = (LAS float*)F.lds;
        LAS float* red = (LAS float*)(F.lds + 32768);
        for (int i = F.tid; i < NB * D; i += NTHR) { const float v = P.c[i]; cact[i] = v / (1.0f + expf(-v)); }
        __syncthreads();
        float* MOD = (float*)(ws + WS_MOD);
        for (int task = F.bid; task < DEPTH * 384; task += F.G) {
            const int l = task / 384, nc = task % 384, col = F.lane & 31, n = nc * 32 + col, k0 = F.wave * 256 + (F.lane >> 5) * 128;
            float acc[NB];
#pragma unroll
            for (int b = 0; b < NB; ++b) acc[b] = 0.f;
            const float* wp = P.w_ada + ((size_t)l * D + k0) * (6 * D) + n;
#pragma unroll 16
            for (int i = 0; i < 128; ++i) { const float wv = wp[(size_t)i * 6 * D];
#pragma unroll
                for (int b = 0; b < NB; ++b) acc[b] += wv * cact[b * D + k0 + i]; }
#pragma unroll
            for (int b = 0; b < NB; ++b) { acc[b] += shx(acc[b], 32, F.lane); if (F.lane < 32) red[(F.wave * NB + b) * 32 + col] = acc[b]; }
            __syncthreads();
            if (F.tid < NB * 32) { const int b = F.tid >> 5, nn = F.tid & 31; float s = 0.f;
#pragma unroll
                for (int w = 0; w < 8; ++w) s += red[(w * NB + b) * 32 + nn];
                MOD[((size_t)l * NB + b) * 6 * D + nc * 32 + nn] = s + P.b_ada[(size_t)l * 6 * D + nc * 32 + nn]; }
            __syncthreads();
        }
    }
}

template <int MODE, bool XBF>
DI void norm_phase(Frame& F, const void* xin_, const float* mod_sh, const float* mod_sc, const bf16_t* W16T, const float* bias16, bf16_t* Hout, unsigned char* H8out, float* out16) {
    constexpr int HROW = 4096 + 16;
    LAS unsigned char* HT = F.lds;
    LAS float* PP = (LAS float*)(F.lds + 16 * HROW);
    const int w = F.wave, lane = F.lane, l15 = lane & 15, kq = lane >> 4, tid = F.tid;
    bf16x8 bw[8];
#pragma unroll
    for (int i = 0; i < 8; ++i) bw[i] = *(const bf16x8*)(W16T + (size_t)l15 * D + 32 * (8 * w + i) + 8 * kq);
    typedef typename std::conditional<XBF, u32x4, f32x4>::type raw_t;
    raw_t vr[2][4][XBF ? 1 : 2];
#define NP_LOAD(blk_) do { _Pragma("unroll") for (int rr = 0; rr < 2; ++rr) { const size_t xo = (size_t)((blk_) * 16 + 2 * w + rr) * D + 8 * lane; \
        _Pragma("unroll") for (int j = 0; j < 4; ++j) { if constexpr (XBF) vr[rr][j][0] = *(const u32x4*)((const bf16_t*)xin_ + xo + 512 * j); \
            else { vr[rr][j][0] = *(const f32x4*)((const float*)xin_ + xo + 512 * j); vr[rr][j][1] = *(const f32x4*)((const float*)xin_ + xo + 512 * j + 4); } } } } while (0)
    if (F.bid < MTOK / 16) NP_LOAD(F.bid);
    for (int blk = F.bid; blk < MTOK / 16; blk += F.G) {
        __syncthreads();
        float v[2][4][8];
#pragma unroll
        for (int rr = 0; rr < 2; ++rr)
#pragma unroll
            for (int j = 0; j < 4; ++j) {
                if constexpr (XBF) unpack8(vr[rr][j][0], v[rr][j]);
                else {
#pragma unroll
                    for (int e = 0; e < 4; ++e) { v[rr][j][e] = vr[rr][j][0][e]; v[rr][j][4 + e] = vr[rr][j][1][e]; } } }
        if (blk + F.G < MTOK / 16) NP_LOAD(blk + F.G);
#pragma unroll
        for (int rr = 0; rr < 2; ++rr) {
            const int row = blk * 16 + 2 * w + rr, b = row / SEQ;
            float ss = 0.f;
#pragma unroll
            for (int j = 0; j < 4; ++j)
#pragma unroll
                for (int e = 0; e < 8; ++e) ss += v[rr][j][e] * v[rr][j][e];
            ss = wave_sum(ss, lane);
            const float rstd = 1.0f / sqrtf(ss * (1.0f / D) + EPS);
            const float* shp = mod_sh + (size_t)b * 6 * D + 8 * lane; const float* scp = mod_sc + (size_t)b * 6 * D + 8 * lane;
            bf16_t* hr = Hout + (size_t)row * D + 8 * lane;
            LAS unsigned char* hl = HT + (2 * w + rr) * HROW + 16 * lane;
#pragma unroll
            for (int j = 0; j < 4; ++j) { const f32x4 sh0 = *(const f32x4*)(shp + 512 * j), sh1 = *(const f32x4*)(shp + 512 * j + 4), sc0 = *(const f32x4*)(scp + 512 * j), sc1 = *(const f32x4*)(scp + 512 * j + 4);
                float hv[8];
#pragma unroll
                for (int e = 0; e < 4; ++e) { hv[e] = v[rr][j][e] * rstd * (sc0[e] + 1.0f) + sh0[e]; hv[4 + e] = v[rr][j][4 + e] * rstd * (sc1[e] + 1.0f) + sh1[e]; }
                const u32x4 o = pack8(hv); *(LAS u32x4*)(hl + 1024 * j) = o;
                if (MODE == 0) *(u32x4*)(hr + 512 * j) = o;
                u32x2 o8; o8.x = pg8::pk4_fp8(hv[0], hv[1], hv[2], hv[3]); o8.y = pg8::pk4_fp8(hv[4], hv[5], hv[6], hv[7]);
                *(u32x2*)(H8out + (size_t)row * D + 8 * lane + 512 * j) = o8; }
        }
        __syncthreads();
        f32x4 acc = (f32x4){0.f, 0.f, 0.f, 0.f};
#pragma unroll
        for (int i = 0; i < 8; ++i) { const int ks = 8 * w + i;
            const bf16x8 A = *(const LAS bf16x8*)(HT + l15 * HROW + (32 * ks + 8 * kq) * 2);
            acc = MFMA16(A, bw[i], acc); }
        *(LAS f32x4*)(PP + w * 256 + lane * 4) = acc;
        __syncthreads();
        if (tid < 256) {
            const int r = tid >> 4, n = tid & 15; float val = 0.f;
#pragma unroll
            for (int ww = 0; ww < 8; ++ww) val += PP[ww * 256 + ((r >> 2) * 16 + n) * 4 + (r & 3)];
            if (MODE == 0) val += bias16[n];
            else {
                float m = val;
#pragma unroll
                for (int o = 1; o < 16; o <<= 1) m = fmaxf(m, shx(m, o, lane));
                const float e = expf(val - m); float s = e;
#pragma unroll
                for (int o = 1; o < 16; o <<= 1) s += shx(s, o, lane);
                val = e / s;
            }
            out16[(size_t)(blk * 16 + r) * 16 + n] = val;
        }
    }
#undef NP_LOAD
}

DI unsigned offb(unsigned row, unsigned ch) { return 256u * row + 16u * (ch ^ (((row & 3u) << 2) | ((row >> 2) & 3u))); }
DI s16x4 trrd(const LAS unsigned char* img, unsigned rowbase, unsigned c, int lane) {
    const unsigned blk = (lane >> 4) & 1, q = (lane & 15) >> 2, p = lane & 3;
    return __builtin_amdgcn_ds_read_tr16_b64_v4i16((LAS s16x4*)(img + offb(rowbase + q, 4 * c + 2 * blk + (p >> 1)) + 8 * (p & 1)));
}
DI int crow(int reg, int hh) { return (reg & 3) + 8 * (reg >> 2) + 4 * hh; }
DI unsigned trbase(unsigned rowbase0, unsigned c, int lane) { const unsigned blk = (lane >> 4) & 1, q = (lane & 15) >> 2, p = lane & 3; return offb(rowbase0 + q, 4 * c + 2 * blk + (p >> 1)) + 8 * (p & 1); }
DI s16x4 trat(const LAS unsigned char* p) { return __builtin_amdgcn_ds_read_tr16_b64_v4i16((LAS s16x4*)p); }

DI void attn_unit(Frame& F, int unit, const bf16_t* PROJ, const float* ropec, const float* ropes, const float* qg, const float* kg, const float* sinkp, bf16_t* MIX) {
    LAS unsigned char* KI = F.lds;
    LAS unsigned char* VI = F.lds + 32768;
    const int pair = unit & 1, kvh = (unit >> 1) & 1, qblk = (unit >> 2) & 15, b = unit >> 6;
    const int w = F.wave, lane = F.lane, r = lane & 31, hh = lane >> 5;
    const int head = kvh * 4 + pair * 2 + (w >> 2);
    const int tq0 = qblk * 128 + (w & 3) * 32, tq = tq0 + r;
    constexpr float QS = 0.08838834764831845f * LOG2E;
    bf16x8 qf[8];
    {
        const bf16_t* qrow = PROJ + (size_t)(b * SEQ + tq) * INWG + C_AQ + head * 128 + 8 * hh;
        float x[8][8]; float ss = 0.f;
#pragma unroll
        for (int k = 0; k < 8; ++k) { unpack8(*(const u32x4*)(qrow + 16 * k), x[k]);
#pragma unroll
            for (int j = 0; j < 8; ++j) ss += x[k][j] * x[k][j]; }
        ss += shx(ss, 32, lane);
        const float rstd = __builtin_amdgcn_rsqf(ss * (1.0f / 128.0f) + EPS);
#pragma unroll
        for (int k = 0; k < 8; ++k) { asm volatile("" ::: "memory");
            const f32x4 g0 = *(const f32x4*)(qg + 16 * k + 8 * hh), g1 = *(const f32x4*)(qg + 16 * k + 8 * hh + 4);
#pragma unroll
            for (int j = 0; j < 4; ++j) { x[k][j] *= rstd * g0[j]; x[k][4 + j] *= rstd * g1[j]; } }
#pragma unroll
        for (int k = 0; k < 4; ++k) { asm volatile("" ::: "memory");
            const float* cp = ropec + (size_t)tq * 64 + 16 * k + 8 * hh; const float* sp = ropes + (size_t)tq * 64 + 16 * k + 8 * hh;
            const f32x4 c0 = *(const f32x4*)cp, c1 = *(const f32x4*)(cp + 4), s0 = *(const f32x4*)sp, s1 = *(const f32x4*)(sp + 4);
            float lo[8], hi[8];
#pragma unroll
            for (int j = 0; j < 8; ++j) { const float cc = j < 4 ? c0[j] : c1[j - 4], sn = j < 4 ? s0[j] : s1[j - 4];
                lo[j] = (x[k][j] * cc - x[k + 4][j] * sn) * QS; hi[j] = (x[k + 4][j] * cc + x[k][j] * sn) * QS; }
            qf[k] = __builtin_bit_cast(bf16x8, pack8(lo)); qf[k + 4] = __builtin_bit_cast(bf16x8, pack8(hi));
        }
        asm volatile("" ::: "memory");
    }
    unsigned kro[8], vb[4][2];
#pragma unroll
    for (int ks = 0; ks < 8; ++ks) kro[ks] = offb(r, 2 * ks + hh);
#pragma unroll
    for (int dvt = 0; dvt < 4; ++dvt) { vb[dvt][0] = trbase(4 * hh, dvt, lane); vb[dvt][1] = trbase(4 * hh + 8, dvt, lane); }
    float m_run = sinkp[head] * LOG2E, l_run = 1.0f;
    f32x16 oacc[4];
#pragma unroll
    for (int i = 0; i < 4; ++i)
#pragma unroll
        for (int j = 0; j < 16; ++j) oacc[i][j] = 0.f;
    for (int kbi = -1; kbi <= 1; ++kbi) {
        const int kb = qblk + kbi;
        if (kb < 0 || kb >= SEQ / 128) continue;
        __syncthreads();
        u32x4 kraw[4], vraw[4];
#pragma unroll
        for (int i = 0; i < 4; ++i) { const int task = F.tid + NTHR * i, s = task >> 4, c = task & 15;
            const bf16_t* prow = PROJ + (size_t)(b * SEQ + kb * 128 + s) * INWG;
            kraw[i] = *(const u32x4*)(prow + C_AK + kvh * 128 + 8 * c); vraw[i] = *(const u32x4*)(prow + C_AV + kvh * 128 + 8 * c); }
#pragma unroll
        for (int i = 0; i < 4; ++i) {
            asm volatile("" ::: "memory");
            const int task = F.tid + NTHR * i, s = task >> 4, c = task & 15, pos = kb * 128 + s;
            float x[8], pr[8], o[8]; unpack8(kraw[i], x);
            float ss = 0.f;
#pragma unroll
            for (int j = 0; j < 8; ++j) ss += x[j] * x[j];
            ss += shx(ss, 1, lane); ss += shx(ss, 2, lane); ss += shx(ss, 4, lane); ss += shx(ss, 8, lane);
            const float rstd = __builtin_amdgcn_rsqf(ss * (1.0f / 128.0f) + EPS);
            const f32x4 g0 = *(const f32x4*)(kg + 8 * c), g1 = *(const f32x4*)(kg + 8 * c + 4);
#pragma unroll
            for (int j = 0; j < 8; ++j) x[j] *= rstd * (j < 4 ? g0[j] : g1[j - 4]);
#pragma unroll
            for (int j = 0; j < 8; ++j) pr[j] = shx(x[j], 8, lane);
            const float* cp = ropec + (size_t)pos * 64 + 8 * (c & 7); const float* sp = ropes + (size_t)pos * 64 + 8 * (c & 7);
            const f32x4 c0 = *(const f32x4*)cp, c1 = *(const f32x4*)(cp + 4), s0 = *(const f32x4*)sp, s1 = *(const f32x4*)(sp + 4);
#pragma unroll
            for (int j = 0; j < 8; ++j) { const float cc = j < 4 ? c0[j] : c1[j - 4], sn = j < 4 ? s0[j] : s1[j - 4];
                o[j] = (c < 8) ? (x[j] * cc - pr[j] * sn) : (x[j] * cc + pr[j] * sn); }
            *(LAS u32x4*)(KI + offb(s, c)) = pack8(o);
            *(LAS u32x4*)(VI + offb(s, c)) = vraw[i];
        }
        __syncthreads();
#pragma unroll 1
        for (int sub = 0; sub < 2; ++sub) {
            const int kpos0 = kb * 128 + sub * 64;
            if (kpos0 > tq0 + 31 + 128 || kpos0 + 63 < tq0 - 128) continue;
            f32x16 st[2];
#pragma unroll
            for (int kt = 0; kt < 2; ++kt) { asm volatile("" ::: "memory");
#pragma unroll
                for (int j = 0; j < 16; ++j) st[kt][j] = 0.f;
#pragma unroll
                for (int ks = 0; ks < 8; ++ks) { const bf16x8 a = *(const LAS bf16x8*)(KI + 256 * (sub * 64 + kt * 32) + kro[ks]);
                    st[kt] = MFMA32(a, qf[ks], st[kt]); }
            }
            float mx = -INFINITY;
#pragma unroll
            for (int kt = 0; kt < 2; ++kt)
#pragma unroll
                for (int rg = 0; rg < 16; ++rg) { const int kp = kpos0 + kt * 32 + (rg & 3) + 8 * (rg >> 2) + 4 * hh, dl = kp - tq;
                    const float sv = (dl <= 128 && dl >= -128) ? st[kt][rg] : -INFINITY; st[kt][rg] = sv; mx = fmaxf(mx, sv); }
            mx = fmaxf(mx, shx(mx, 32, lane));
            const float m_new = fmaxf(m_run, mx), alpha = fast_exp2(m_run - m_new);
            float rs = 0.f;
#pragma unroll
            for (int kt = 0; kt < 2; ++kt)
#pragma unroll
                for (int rg = 0; rg < 16; ++rg) { const float p = fast_exp2(st[kt][rg] - m_new); st[kt][rg] = p; rs += p; }
            rs += shx(rs, 32, lane);
            l_run = l_run * alpha + rs; m_run = m_new;
#pragma unroll
            for (int i = 0; i < 4; ++i)
#pragma unroll
                for (int j = 0; j < 16; ++j) oacc[i][j] *= alpha;
            bf16x8 pf[2][2];
#pragma unroll
            for (int kt = 0; kt < 2; ++kt)
#pragma unroll
                for (int s2 = 0; s2 < 2; ++s2) { float t8[8];
#pragma unroll
                    for (int j = 0; j < 8; ++j) t8[j] = st[kt][8 * s2 + j];
                    pf[kt][s2] = __builtin_bit_cast(bf16x8, pack8(t8)); }
#pragma unroll
            for (int dvt = 0; dvt < 4; ++dvt) { asm volatile("" ::: "memory");
#pragma unroll
                for (int kt = 0; kt < 2; ++kt)
#pragma unroll
                    for (int s2 = 0; s2 < 2; ++s2) { const int sb = sub * 64 + kt * 32 + 16 * s2;
                        const s16x4 lo = trat(VI + 256 * sb + vb[dvt][0]), hi = trat(VI + 256 * sb + vb[dvt][1]);
                        const bf16x8 a = __builtin_shufflevector(lo, hi, 0, 1, 2, 3, 4, 5, 6, 7);
                        oacc[dvt] = MFMA32(a, pf[kt][s2], oacc[dvt]); } }
        }
    }
    const float inv = 1.0f / l_run;
    bf16_t* orow = MIX + (size_t)(b * SEQ + tq) * D + head * 128 + 8 * hh;
#pragma unroll
    for (int dvt = 0; dvt < 4; ++dvt)
#pragma unroll
        for (int ip = 0; ip < 2; ++ip) { u32x2 o[2];
#pragma unroll
            for (int q = 0; q < 2; ++q) { const int i = 2 * ip + q; o[q].x = pk2(oacc[dvt][4 * i] * inv, oacc[dvt][4 * i + 1] * inv); o[q].y = pk2(oacc[dvt][4 * i + 2] * inv, oacc[dvt][4 * i + 3] * inv); }
            *(u32x4*)(orow + dvt * 32 + 16 * ip) = widen_pair(o[0], o[1]); }
}

constexpr int ML_L = 256, ML_NC = SEQ / ML_L;
constexpr float ML_SC = 0.08838834764831845f;
DI size_t scal_idx(int dir, int kind, int b, int h) { return ((size_t)((dir * 3 + kind) * NB + b) * 4 + h) * SEQ; }

DI void mlA_unit(Frame& F, int unit, const bf16_t* PROJ, const float* GATES, bf16_t* NUMF, bf16_t* NUMB, float* SCAL, float* U, float* UN, float* AA) {
    LAS unsigned char* KI = F.lds;
    LAS unsigned char* VI = F.lds + 65536;
    LAS float* SA = (LAS float*)(F.lds + 131072);
    LAS float* CS = SA + 6 * 256;
    const int dvh = unit & 1, j = (unit >> 1) & 7, h = (unit >> 4) & 3, b = unit >> 6;
    const int w = F.wave, lane = F.lane, r = lane & 31, hh = lane >> 5, tid = F.tid;
    _Pragma("unroll 1") for (int rp0_ = 0; rp0_ < REP_MLS; ++rp0_) {
    __syncthreads();
    {
        u32x4 kr[8], vr[8];
#pragma unroll
        for (int i = 0; i < 8; ++i) { const int task = tid + NTHR * i, s = task >> 4, ch = task & 15;
            const bf16_t* prow = PROJ + (size_t)(b * SEQ + j * ML_L + s) * INWG;
            kr[i] = *(const u32x4*)(prow + C_MK + h * 128 + 8 * ch); vr[i] = *(const u32x4*)(prow + C_MV + h * 256 + dvh * 128 + 8 * ch); }
        float ka[2][4], kb[2][4], kam[2][4];
#pragma unroll
        for (int dir = 0; dir < 2; ++dir) {
            float ig[4], lf[4];
#pragma unroll
            for (int e = 0; e < 4; ++e) { const int p = w * ML_L + 4 * lane + e, tok = dir ? (SEQ - 1 - p) : p; const float* gp = GATES + (size_t)(b * SEQ + tok) * 16;
                ig[e] = gp[dir * 4 + h]; const float fg = gp[(2 + dir) * 4 + h]; lf[e] = fminf(fg, 0.f) - log1pf(expf(-fabsf(fg))); }
            float bc[4]; bc[0] = lf[0]; bc[1] = bc[0] + lf[1]; bc[2] = bc[1] + lf[2]; bc[3] = bc[2] + lf[3];
            float incl = bc[3];
#pragma unroll
            for (int o = 1; o < 64; o <<= 1) { const float t = shup(incl, o, lane); if (lane >= o) incl += t; }
            const float excl = incl - bc[3], btot = rdlane(incl, 63);
            float am[4];
#pragma unroll
            for (int e = 0; e < 4; ++e) { kb[dir][e] = excl + bc[e]; ka[dir][e] = ig[e] - kb[dir][e]; am[e] = e ? fmaxf(am[e - 1], ka[dir][e]) : ka[dir][0]; }
            float inclm = am[3];
#pragma unroll
            for (int o = 1; o < 64; o <<= 1) { const float t = shup(inclm, o, lane); if (lane >= o) inclm = fmaxf(inclm, t); }
            float exclm = shup(inclm, 1, lane); if (lane == 0) exclm = -INFINITY;
#pragma unroll
            for (int e = 0; e < 4; ++e) kam[dir][e] = fmaxf(exclm, am[e]);
            if (lane == 0) { CS[(dir * 8 + w) * 2] = btot; CS[(dir * 8 + w) * 2 + 1] = btot + rdlane(inclm, 63); }
        }
#pragma unroll
        for (int i = 0; i < 8; ++i) { const int task = tid + NTHR * i, s = task >> 4, ch = task & 15;
            *(LAS u32x4*)(KI + offb(s, ch)) = kr[i]; *(LAS u32x4*)(VI + offb(s, ch)) = vr[i]; }
        __syncthreads();
#pragma unroll
        for (int dir = 0; dir < 2; ++dir) {
            const int c = dir ? (ML_NC - 1 - j) : j;
            if (w == c) {
                float m_prev = 0.f;
                for (int cc = 0; cc < c; ++cc) m_prev = fmaxf(CS[(dir * 8 + cc) * 2] + m_prev, CS[(dir * 8 + cc) * 2 + 1]);
                const float btot = CS[(dir * 8 + c) * 2], m_new = fmaxf(btot + m_prev, CS[(dir * 8 + c) * 2 + 1]);
                if (lane == 0) AA[((dir * NB + b) * 4 + h) * ML_NC + c] = expf(btot + m_prev - m_new);
#pragma unroll
                for (int e = 0; e < 4; ++e) { const int pl = 4 * lane + e, toff = dir ? (ML_L - 1 - pl) : pl;
                    const float mm = fmaxf(kam[dir][e], m_prev);
                    SA[(dir * 3 + 0) * 256 + toff] = ka[dir][e] * LOG2E - 3.5f; SA[(dir * 3 + 1) * 256 + toff] = mm * LOG2E;     SA[(dir * 3 + 2) * 256 + toff] = expf(btot + ka[dir][e] - m_new);
                    if (dvh == 0) { const int tok = j * ML_L + toff;
                        SCAL[scal_idx(dir, 1, b, h) + tok] = expf(m_prev - mm) * ML_SC; SCAL[scal_idx(dir, 2, b, h) + tok] = expf(-(kb[dir][e] + mm)); } }
            }
        }
        __syncthreads();
    }
    }
    _Pragma("unroll 1") for (int rp1_ = 0; rp1_ < REP_ML1; ++rp1_) {
        const int tok = j * ML_L + 32 * w + r;
        bf16x8 qf[8];
        { const bf16_t* qrow = PROJ + (size_t)(b * SEQ + tok) * INWG + C_MQ + h * 128 + 8 * hh;
#pragma unroll
            for (int ks = 0; ks < 8; ++ks) qf[ks] = *(const bf16x8*)(qrow + 16 * ks); }
        unsigned kb[8], vb[4][2];
#pragma unroll
        for (int ks = 0; ks < 8; ++ks) kb[ks] = offb(r, 2 * ks + hh);
#pragma unroll
        for (int dvt = 0; dvt < 4; ++dvt) { vb[dvt][0] = trbase(4 * hh, dvt, lane); vb[dvt][1] = trbase(4 * hh + 8, dvt, lane); }
#pragma unroll 1
        for (int dir = 0; dir < 2; ++dir) {
            const LAS float* a_s = SA + (dir * 3 + 0) * 256; const float mm_t = SA[(dir * 3 + 1) * 256 + 32 * w + r];
            f32x16 oacc[4];
#pragma unroll
            for (int i = 0; i < 4; ++i)
#pragma unroll
                for (int q = 0; q < 16; ++q) oacc[i][q] = 0.f;
            float den = 0.f;
            const int k_lo = dir ? w : 0, k_hi = dir ? 7 : w;
#pragma unroll 1
            for (int kti = k_lo; kti <= k_hi; ++kti) {
                const int s0 = 32 * kti;
                const LAS unsigned char* kt = KI + 256 * s0; const LAS unsigned char* vt = VI + 256 * s0;
                f32x16 st;
#pragma unroll
                for (int q = 0; q < 16; ++q) st[q] = 0.f;
#pragma unroll
                for (int ks = 0; ks < 8; ++ks) { const bf16x8 a = *(const LAS bf16x8*)(kt + kb[ks]); st = MFMA32(a, qf[ks], st); }
                const bool diag = (kti == w);
#pragma unroll
                for (int g = 0; g < 4; ++g) { const f32x4 av = *(const LAS f32x4*)(a_s + s0 + 8 * g + 4 * hh);
#pragma unroll
                    for (int e = 0; e < 4; ++e) { const int sl = 8 * g + 4 * hh + e;
                        const bool ok = !diag || (dir ? (sl >= r) : (sl <= r));
                        const float p = ok ? st[4 * g + e] * fast_exp2(av[e] - mm_t) : 0.f; st[4 * g + e] = p; den += p; } }
                bf16x8 pf[2];
#pragma unroll
                for (int s2 = 0; s2 < 2; ++s2) { float t8[8];
#pragma unroll
                    for (int q = 0; q < 8; ++q) t8[q] = st[8 * s2 + q];
                    pf[s2] = __builtin_bit_cast(bf16x8, pack8(t8)); }
#pragma unroll
                for (int dvt = 0; dvt < 4; ++dvt)
#pragma unroll
                    for (int s2 = 0; s2 < 2; ++s2) { const s16x4 lo = trat(vt + vb[dvt][0] + 4096 * s2), hi = trat(vt + vb[dvt][1] + 4096 * s2);
                        const bf16x8 a = __builtin_shufflevector(lo, hi, 0, 1, 2, 3, 4, 5, 6, 7);
                        oacc[dvt] = MFMA32(a, pf[s2], oacc[dvt]); }
            }
            den += shx(den, 32, lane);
            bf16_t* NUM = dir ? NUMB : NUMF;
            bf16_t* orow = NUM + (size_t)(b * SEQ + tok) * 1024 + h * 256 + dvh * 128 + 8 * hh;
#pragma unroll
            for (int dvt = 0; dvt < 4; ++dvt)
#pragma unroll
                for (int gp = 0; gp < 2; ++gp) { u32x2 o[2];
#pragma unroll
                    for (int q = 0; q < 2; ++q) { const int g = 2 * gp + q; o[q].x = pk2(oacc[dvt][4 * g], oacc[dvt][4 * g + 1]); o[q].y = pk2(oacc[dvt][4 * g + 2], oacc[dvt][4 * g + 3]); }
                    *(u32x4*)(orow + dvt * 32 + 16 * gp) = widen_pair(o[0], o[1]); }
            if (dvh == 0 && hh == 0) SCAL[scal_idx(dir, 0, b, h) + tok] = den;
        }
    }
    _Pragma("unroll 1") for (int rp2_ = 0; rp2_ < REP_ML2; ++rp2_) {
        const int dvt = w & 3, dkt0 = 2 * (w >> 2);
        f32x16 ua[2][2];
#pragma unroll
        for (int d = 0; d < 2; ++d)
#pragma unroll
            for (int i = 0; i < 2; ++i)
#pragma unroll
                for (int q = 0; q < 16; ++q) ua[d][i][q] = 0.f;
        const unsigned vb0 = trbase(8 * hh, dvt, lane), vb1 = trbase(8 * hh + 4, dvt, lane);
        unsigned kb0[2], kb1[2];
#pragma unroll
        for (int i = 0; i < 2; ++i) { kb0[i] = trbase(8 * hh, dkt0 + i, lane); kb1[i] = trbase(8 * hh + 4, dkt0 + i, lane); }
#pragma unroll 2
        for (int ks = 0; ks < 16; ++ks) {
            const int s0 = 16 * ks;
            const s16x4 vlo = trat(VI + vb0 + 4096 * ks), vhi = trat(VI + vb1 + 4096 * ks);
            float v8[8]; unpack8(__builtin_bit_cast(u32x4, __builtin_shufflevector(vlo, vhi, 0, 1, 2, 3, 4, 5, 6, 7)), v8);
            bf16x8 bw[2];
#pragma unroll
            for (int d = 0; d < 2; ++d) { const f32x4 wa = *(const LAS f32x4*)(SA + (d * 3 + 2) * 256 + s0 + 8 * hh), wb = *(const LAS f32x4*)(SA + (d * 3 + 2) * 256 + s0 + 8 * hh + 4);
                float x8[8];
#pragma unroll
                for (int q = 0; q < 4; ++q) { x8[q] = v8[q] * wa[q]; x8[4 + q] = v8[4 + q] * wb[q]; }
                bw[d] = __builtin_bit_cast(bf16x8, pack8(x8)); }
#pragma unroll
            for (int i = 0; i < 2; ++i) { const s16x4 klo = trat(KI + kb0[i] + 4096 * ks), khi = trat(KI + kb1[i] + 4096 * ks);
                const bf16x8 a = __builtin_shufflevector(klo, khi, 0, 1, 2, 3, 4, 5, 6, 7);
                ua[0][i] = MFMA32(bw[0], a, ua[0][i]); ua[1][i] = MFMA32(bw[1], a, ua[1][i]); }
        }
#pragma unroll
        for (int d = 0; d < 2; ++d) { const int c = d ? (ML_NC - 1 - j) : j;
            float* up = U + ((size_t)(((d * NB + b) * 4 + h) * ML_NC + c) * 128) * 256 + dvh * 128 + dvt * 32 + 4 * hh;
#pragma unroll
            for (int i = 0; i < 2; ++i)
#pragma unroll
                for (int g = 0; g < 4; ++g) *(f32x4*)(up + (size_t)(32 * (dkt0 + i) + r) * 256 + 8 * g) = (f32x4){ua[d][i][4 * g], ua[d][i][4 * g + 1], ua[d][i][4 * g + 2], ua[d][i][4 * g + 3]}; }
        if (dvh == 0) {
            const int dkt = w & 3, d = w >> 2, c = d ? (ML_NC - 1 - j) : j;
            const unsigned k0 = trbase(8 * hh, dkt, lane), k1 = trbase(8 * hh + 4, dkt, lane);
            f32x16 un;
#pragma unroll
            for (int q = 0; q < 16; ++q) un[q] = 0.f;
#pragma unroll 4
            for (int ks = 0; ks < 16; ++ks) {
                const f32x4 wa = *(const LAS f32x4*)(SA + (d * 3 + 2) * 256 + 16 * ks + 8 * hh), wb = *(const LAS f32x4*)(SA + (d * 3 + 2) * 256 + 16 * ks + 8 * hh + 4);
                u32x4 bwv; bwv.x = pk2(wa[0], wa[1]); bwv.y = pk2(wa[2], wa[3]); bwv.z = pk2(wb[0], wb[1]); bwv.w = pk2(wb[2], wb[3]);
                const s16x4 klo = trat(KI + k0 + 4096 * ks), khi = trat(KI + k1 + 4096 * ks);
                const bf16x8 a = __builtin_shufflevector(klo, khi, 0, 1, 2, 3, 4, 5, 6, 7);
                un = MFMA32(__builtin_bit_cast(bf16x8, bwv), a, un); }
            if (hh == 0) UN[((size_t)((d * NB + b) * 4 + h) * ML_NC + c) * 128 + 32 * dkt + r] = un[0];
        }
    }
}

DI void mlB_phase(Frame& F, const float* U, const float* UN, const float* AA, bf16_t* CPREV, float* NPREV) {
    const int gt = F.bid * NTHR + F.tid, NT = F.G * NTHR;
    for (int item = gt; item < 32 * 8192; item += NT) {
        const int sq = item >> 13, e4 = item & 8191;
        f32x4 C = (f32x4){0.f, 0.f, 0.f, 0.f};
        f32x4 u[ML_NC - 1];
#pragma unroll
        for (int c = 0; c < ML_NC - 1; ++c) u[c] = *(const f32x4*)(U + ((size_t)(sq * ML_NC + c) * 8192 + e4) * 4);
#pragma unroll
        for (int c = 0; c < ML_NC - 1; ++c) { C = C * AA[sq * ML_NC + c] + u[c];
            u32x2 o; o.x = pk2(C.x, C.y); o.y = pk2(C.z, C.w); *(u32x2*)(CPREV + ((size_t)(sq * (ML_NC - 1) + c) * 8192 + e4) * 4) = o; }
    }
    for (int item = gt; item < 32 * 128; item += NT) {
        const int sq = item >> 7, dk = item & 127; float n = 0.f;
#pragma unroll
        for (int c = 0; c < ML_NC - 1; ++c) { n = n * AA[sq * ML_NC + c] + UN[(size_t)(sq * ML_NC + c) * 128 + dk]; NPREV[(size_t)(sq * (ML_NC - 1) + c) * 128 + dk] = n; }
    }
}

DI void mlC_unit(Frame& F, int unit, const bf16_t* PROJ, const bf16_t* NUMF, const bf16_t* NUMB, const float* SCAL, const bf16_t* CPREV, const float* NPREV, const float* m_gain, bf16_t* MIX) {
    LAS unsigned char* CI = F.lds;
    LAS float* NP = (LAS float*)(F.lds + 131072);
    LAS float* EX = NP + 256;
    const int th = unit & 1, j = (unit >> 1) & 7, h = (unit >> 4) & 3, b = unit >> 6;
    const int w = F.wave, lane = F.lane, r = lane & 31, hh = lane >> 5, tid = F.tid, tt = w >> 1, dh = w & 1;
    unsigned zz_ = 0u; asm volatile("" : "+v"(zz_));
    const int tok = j * ML_L + th * 128 + tt * 32 + r;
    bf16x8 qf[8];
    { const bf16_t* qrow = PROJ + (size_t)(b * SEQ + tok) * INWG + C_MQ + h * 128 + 8 * hh;
#pragma unroll
        for (int ks = 0; ks < 8; ++ks) qf[ks] = *(const bf16x8*)(qrow + 16 * ks); }
    float sc_den[2], sc_ei[2], sc_emt[2];
#pragma unroll
    for (int d = 0; d < 2; ++d) { sc_den[d] = SCAL[scal_idx(d, 0, b, h) + tok]; sc_ei[d] = SCAL[scal_idx(d, 1, b, h) + tok]; sc_emt[d] = SCAL[scal_idx(d, 2, b, h) + tok]; }
    __syncthreads();
#pragma unroll
    for (int d = 0; d < 2; ++d) { const int c = d ? (ML_NC - 1 - j) : j; const int sq = (d * NB + b) * 4 + h;
        const bf16_t* src = CPREV + (size_t)(sq * (ML_NC - 1) + (c > 0 ? c - 1 : 0)) * 32768;
#pragma unroll
        for (int i = 0; i < 8; ++i) { const int task = tid + NTHR * i, dk = task >> 5, ch = task & 31;
            u32x4 v = (u32x4){zz_, zz_, zz_, zz_}; if (c > 0) v = *(const u32x4*)(src + (size_t)dk * 256 + 8 * ch);
            *(LAS u32x4*)(CI + (d * 2 + (ch >> 4)) * 32768 + offb(dk, ch & 15)) = v; }
        if (tid < 128) NP[d * 128 + tid] = c > 0 ? NPREV[(size_t)(sq * (ML_NC - 1) + (c - 1)) * 128 + tid] : 0.f; }
    __syncthreads();
    unsigned cb[4][2];
#pragma unroll
    for (int dvt = 0; dvt < 4; ++dvt) { cb[dvt][0] = trbase(8 * hh, dvt, lane); cb[dvt][1] = trbase(8 * hh + 4, dvt, lane); }
    float eiv[2], inv[2];
#pragma unroll
    for (int d = 0; d < 2; ++d) {
        const int c = d ? (ML_NC - 1 - j) : j;
        float qn = 0.f;
#pragma unroll
        for (int ks = 0; ks < 8; ++ks) { float q8[8]; unpack8(__builtin_bit_cast(u32x4, qf[ks]), q8);
            const f32x4 na = *(const LAS f32x4*)(NP + d * 128 + 16 * ks + 8 * hh), nb = *(const LAS f32x4*)(NP + d * 128 + 16 * ks + 8 * hh + 4);
            qn += (q8[0] * na[0] + q8[1] * na[1]) + (q8[2] * na[2] + q8[3] * na[3]) + (q8[4] * nb[0] + q8[5] * nb[1]) + (q8[6] * nb[2] + q8[7] * nb[3]); }
        qn += shx(qn, 32, lane);
        const float deni = sc_den[d], ei = sc_ei[d], emt = sc_emt[d];
        eiv[d] = ei; inv[d] = 1.0f / fmaxf(fabsf(deni + ei * qn), emt);
    }
    float hs[4][16];
#pragma unroll
    for (int dvt = 0; dvt < 4; ++dvt) {
#pragma unroll
        for (int d = 0; d < 2; ++d) { asm volatile("" ::: "memory");
            const bf16_t* nrow = (d ? NUMB : NUMF) + (size_t)(b * SEQ + tok) * 1024 + h * 256 + dh * 128 + 8 * hh;
            const LAS unsigned char* img = CI + (d * 2 + dh) * 32768;
            f32x16 acc;
#pragma unroll
            for (int q = 0; q < 16; ++q) acc[q] = 0.f;
#pragma unroll
            for (int ks = 0; ks < 8; ++ks) { const s16x4 lo = trat(img + cb[dvt][0] + 4096 * ks), hi = trat(img + cb[dvt][1] + 4096 * ks);
                const bf16x8 a = __builtin_shufflevector(lo, hi, 0, 1, 2, 3, 4, 5, 6, 7);
                acc = MFMA32(a, qf[ks], acc); }
#pragma unroll
            for (int gp = 0; gp < 2; ++gp) { u32x2 nr2[2]; narrow_pair(*(const u32x4*)(nrow + dvt * 32 + 16 * gp), nr2[0], nr2[1]);
#pragma unroll
                for (int q = 0; q < 2; ++q) { const int g = 2 * gp + q; const u32x2 nr = nr2[q];
                    const float nv[4] = {__uint_as_float(nr.x << 16), __uint_as_float(nr.x & 0xffff0000u), __uint_as_float(nr.y << 16), __uint_as_float(nr.y & 0xffff0000u)};
#pragma unroll
                    for (int e = 0; e < 4; ++e) { const float v = (nv[e] + eiv[d] * acc[4 * g + e]) * inv[d]; hs[dvt][4 * g + e] = d ? hs[dvt][4 * g + e] + v : v; } } } }
    }
    float ss = 0.f;
#pragma unroll
    for (int i = 0; i < 4; ++i)
#pragma unroll
        for (int q = 0; q < 16; ++q) ss += hs[i][q] * hs[i][q];
    ss += shx(ss, 32, lane);
    if (hh == 0) EX[w * 32 + r] = ss;
    __syncthreads();
    ss += EX[(w ^ 1) * 32 + r];
    const float rstd = 1.0f / sqrtf(ss * (1.0f / 256.0f) + EPS);
    const int colb = h * 256 + dh * 128 + 4 * hh, colw = h * 256 + dh * 128 + 8 * hh;
    const bf16_t* morow = PROJ + (size_t)(b * SEQ + tok) * INWG + C_MO + colw;
    bf16_t* orow = MIX + (size_t)(b * SEQ + tok) * D + 1024 + colw;
#pragma unroll
    for (int dvt = 0; dvt < 4; ++dvt) { asm volatile("" ::: "memory");
#pragma unroll
        for (int gp = 0; gp < 2; ++gp) { u32x2 mo2[2], o2[2]; narrow_pair(*(const u32x4*)(morow + dvt * 32 + 16 * gp), mo2[0], mo2[1]);
#pragma unroll
            for (int q = 0; q < 2; ++q) { const int g = 2 * gp + q; const f32x4 mg = *(const f32x4*)(m_gain + colb + dvt * 32 + 8 * g); const u32x2 mo = mo2[q];
                const float m0 = __uint_as_float(mo.x << 16), m1 = __uint_as_float(mo.x & 0xffff0000u), m2 = __uint_as_float(mo.y << 16), m3 = __uint_as_float(mo.y & 0xffff0000u);
                const float r0 = hs[dvt][4 * g] * rstd * mg.x * fast_rcp(1.0f + fast_exp2(-m0 * LOG2E)), r1 = hs[dvt][4 * g + 1] * rstd * mg.y * fast_rcp(1.0f + fast_exp2(-m1 * LOG2E));
                const float r2 = hs[dvt][4 * g + 2] * rstd * mg.z * fast_rcp(1.0f + fast_exp2(-m2 * LOG2E)), r3 = hs[dvt][4 * g + 3] * rstd * mg.w * fast_rcp(1.0f + fast_exp2(-m3 * LOG2E));
                o2[q].x = pk2(r0, r1); o2[q].y = pk2(r2, r3); }
            *(u32x4*)(orow + dvt * 32 + 16 * gp) = widen_pair(o2[0], o2[1]); } }
}

DI void select_pair(Frame& F, const int nsel, const int (&bb)[2], const int (&ee)[2], const bool (&publish)[2], const float* AFF, LAS int* tbl, LAS unsigned* scr, float* GATEV, int* SLOT) {
    const int tid = F.tid, lane = F.lane, w = F.wave;
    unsigned key[2][4];
#pragma unroll
    for (int s = 0; s < 2; ++s)
#pragma unroll
        for (int i = 0; i < 4; ++i) key[s][i] = (s < nsel) ? __float_as_uint(AFF[(size_t)(bb[s] * SEQ + 4 * tid + i) * 16 + ee[s]]) : 0u;
    unsigned lo[2] = {0u, 0u};
    __syncthreads();
#pragma unroll 1
    for (int step = 0; step < 16; ++step) {
        const int sh = step < 15 ? 29 - 2 * step : 0; const int ncand = step < 15 ? 3 : 1;
        LAS unsigned* buf = scr + (step & 1) * 48;
#pragma unroll
        for (int s = 0; s < 2; ++s)
#pragma unroll
            for (int c = 0; c < 3; ++c) { const unsigned cand = lo[s] | ((unsigned)(c + 1) << sh);
                int cnt = 0;
#pragma unroll
                for (int i = 0; i < 4; ++i) cnt += __builtin_popcountll(__builtin_amdgcn_ballot_w64(key[s][i] >= cand));
                if (lane == 0) buf[(s * 3 + c) * 8 + w] = (unsigned)cnt; }
        __syncthreads();
#pragma unroll
        for (int s = 0; s < 2; ++s) { unsigned pick = 0u;
#pragma unroll
            for (int c = 0; c < 3; ++c) { unsigned tot = 0u;
#pragma unroll
                for (int ww = 0; ww < 8; ++ww) tot += buf[(s * 3 + c) * 8 + ww];
                if (c < ncand && tot >= (unsigned)CAP) pick = (unsigned)(c + 1); }
            lo[s] |= pick << sh; }
    }
    unsigned pc[2];
#pragma unroll
    for (int s = 0; s < 2; ++s) { unsigned ng = 0u, nq = 0u;
#pragma unroll
        for (int i = 0; i < 4; ++i) { ng += key[s][i] > lo[s]; nq += key[s][i] == lo[s]; }
        pc[s] = ng | (nq << 16); }
    unsigned incl[2] = {pc[0], pc[1]};
#pragma unroll
    for (int o = 1; o < 64; o <<= 1)
#pragma unroll
        for (int s = 0; s < 2; ++s) { const unsigned t = (unsigned)__builtin_amdgcn_ds_bpermute((lane >= o ? lane - o : lane) << 2, (int)incl[s]); if (lane >= o) incl[s] += t; }
    LAS unsigned* wt = scr + 96;
    if (lane == 63) { wt[w] = incl[0]; wt[8 + w] = incl[1]; }
    __syncthreads();
#pragma unroll
    for (int s = 0; s < 2; ++s) if (s < nsel) {
        unsigned before = incl[s] - pc[s], total = 0u;
#pragma unroll
        for (int ww = 0; ww < 8; ++ww) { const unsigned t = wt[s * 8 + ww]; total += t; if (ww < w) before += t; }
        const unsigned need = (unsigned)CAP - (total & 0xffffu);
        unsigned bg = before & 0xffffu, bq = before >> 16;
        const int be = bb[s] * NE + ee[s];
#pragma unroll
        for (int i = 0; i < 4; ++i) { const bool gt = key[s][i] > lo[s], eq = key[s][i] == lo[s];
            const bool selv = gt || (eq && bq < need);
            const int slot = (int)(bg + (bq < need ? bq : need));
            const int row = bb[s] * SEQ + 4 * tid + i;
            if (selv) { tbl[s * 256 + slot] = row; if (publish[s]) GATEV[be * CAP + slot] = __uint_as_float(key[s][i]); }
            if (publish[s]) SLOT[(size_t)row * 16 + ee[s]] = selv ? slot : -1;
            bg += gt; bq += eq; }
    }
    __syncthreads();
}

template <bool OBF>
DI void combine_phase(Frame& F, const bf16_t* X1, const float* g2, const int* SLOT, const bf16_t* YE, void* OUT) {
    const int gw = F.bid * NWAVES + F.wave, NGW = F.G * NWAVES, lane = F.lane;
    for (int row = gw; row < MTOK; row += NGW) {
        const int b = row / SEQ;
        const int sl = SLOT[(size_t)row * 16 + (lane & 15)];
        float acc[4][8];
#pragma unroll
        for (int j = 0; j < 4; ++j)
#pragma unroll
            for (int i = 0; i < 8; ++i) acc[j][i] = 0.f;
        for (int e = 0; e < NE; ++e) { const int s = __builtin_amdgcn_readlane(sl, e);
            if (s >= 0) { const bf16_t* yr = YE + ((size_t)(b * NE + e) * CAP + s) * D + 8 * lane;
#pragma unroll
                for (int j = 0; j < 4; ++j) { float x8[8]; unpack8(*(const u32x4*)(yr + 512 * j), x8);
#pragma unroll
                    for (int i = 0; i < 8; ++i) acc[j][i] += x8[i]; } } }
#pragma unroll
        for (int j = 0; j < 4; ++j) { const int col = 512 * j + 8 * lane;
            float x8[8]; unpack8(*(const u32x4*)(X1 + (size_t)row * D + col), x8);
            const f32x4 ga = *(const f32x4*)(g2 + (size_t)b * 6 * D + col), gb = *(const f32x4*)(g2 + (size_t)b * 6 * D + col + 4);
#pragma unroll
            for (int i = 0; i < 4; ++i) { x8[i] += ga[i] * acc[j][i]; x8[4 + i] += gb[i] * acc[j][4 + i]; }
            if (OBF) *(u32x4*)((bf16_t*)OUT + (size_t)row * D + col) = pack8(x8);
            else { *(f32x4*)((float*)OUT + (size_t)row * D + col) = (f32x4){x8[0], x8[1], x8[2], x8[3]}; *(f32x4*)((float*)OUT + (size_t)row * D + col + 4) = (f32x4){x8[4], x8[5], x8[6], x8[7]}; } }
    }
}

struct Args { const float* in[15]; float* out; unsigned char* ws; int ph_lo, ph_hi; };
constexpr int PPL = 10;
constexpr int N_PHASES = 1 + PPL * DEPTH;
typedef const __attribute__((address_space(4))) Args* KArgs;
#ifndef PH_MASK
#define PH_MASK 0x7FF
#endif
#define PHASE_ENV() KArgs ap = (KArgs)__builtin_amdgcn_kernarg_segment_ptr(); asm volatile("" : "+s"(ap)); unsigned char* const ws = ap->ws; (void)ws; \
    Frame F = F0; { int t_ = F0.tid, b_ = F0.bid, g_ = F0.G; asm volatile("" : "+v"(t_), "+s"(b_), "+s"(g_)); F.tid = t_; F.lane = t_ & 63; F.wave = __builtin_amdgcn_readfirstlane(t_ >> 6); F.bid = b_; F.G = g_; }

__global__ void __launch_bounds__(NTHR, 2) hymba_fwd(Args args) {
    extern __shared__ __attribute__((aligned(16))) unsigned char lds_raw[];
    Frame F0; F0.lds = (LAS unsigned char*)lds_raw; F0.tid = threadIdx.x; F0.lane = F0.tid & 63; F0.wave = __builtin_amdgcn_readfirstlane(F0.tid >> 6); F0.G = gridDim.x; F0.bid = blockIdx.x;
    const int lo = args.ph_lo, hi = args.ph_hi;
    volatile LAS unsigned* misc = (volatile LAS unsigned*)(F0.lds + LDS_MISC);
    if (F0.tid < 4) misc[F0.tid] = 0u;
    __syncthreads();
    XcdBarrier bar; bar.bar = (unsigned*)(args.ws + WS_CTL); bar.x = 0; bar.st = misc;
    if (hi - lo > 1) bar = xcd_barrier_post((unsigned*)(args.ws + WS_CTL), misc);
#define PHK(k) ((k) == 0 ? 0 : (((k) - 1) % PPL) + 1)
#define IN(k) (((PH_MASK >> PHK(k)) & 1) && lo <= (k) && (k) < hi)
#define SEAM(k) do { if ((k) + 1 < hi) xcd_barrier(bar); } while (0)
#ifndef REP_MASK
#define REP_MASK 0
#endif

#define REPLOOP(k) _Pragma("unroll 1") for (int rep_ = 0, nrep_ = (((REP_MASK >> PHK(k)) & 1) ? 2 : 1); rep_ < nrep_; ++rep_, __syncthreads())

    if (IN(0)) {
        PHASE_ENV();
        Ptrs P; P.x = ap->in[0]; P.c = ap->in[1]; P.w_ada = ap->in[2]; P.b_ada = ap->in[3]; P.w_in = ap->in[4]; P.b_gates = ap->in[5]; P.q_gain = ap->in[6]; P.k_gain = ap->in[7];
        P.sink = ap->in[8]; P.m_gain = ap->in[9]; P.w_out = ap->in[10]; P.w_router = ap->in[11]; P.w_gate = ap->in[12]; P.w_up = ap->in[13]; P.w_down = ap->in[14]; P.out = ap->out; P.ws = ws;
        REPLOOP(0) p0_prologue(F, P, rep_ == 0); SEAM(0);
    }

#pragma unroll 1
    for (int l = 0; l < DEPTH; ++l) {
        const int pb = 1 + PPL * l;
        if (IN(pb + 0)) REPLOOP(pb + 0) { PHASE_ENV();
            const float* MOD = (const float*)(ws + WS_MOD) + (size_t)l * NB * 6 * D;
            const bf16_t* w16 = (const bf16_t*)(ws + WS_W16) + (size_t)(l * 2 + 0) * 16 * D;
            if (l == 0) norm_phase<0, false>(F, ap->in[0], MOD + 0 * D, MOD + 1 * D, w16, ap->in[5] + l * 16, (bf16_t*)(ws + WS_H), (unsigned char*)(ws + WS_H8), (float*)(ws + WS_GATES));
            else norm_phase<0, true>(F, ws + WS_X2, MOD + 0 * D, MOD + 1 * D, w16, ap->in[5] + l * 16, (bf16_t*)(ws + WS_H), (unsigned char*)(ws + WS_H8), (float*)(ws + WS_GATES));
        } if (IN(pb + 0)) SEAM(pb + 0);
        if (IN(pb + 1)) REPLOOP(pb + 1) { PHASE_ENV();
            pg8::SchedPlain<2 * D> S{(const bf16_t*)(ws + WS_H), (const bf16_t*)(ws + WS_WIN) + (size_t)l * INWG * D, MTOK / 256, INWA / 256, F.G, F.bid}; pg8::EpiStoreBf16 E{(bf16_t*)(ws + WS_PROJ), INWG, 1.0f};
            pg8::gemm_phase<2 * D, false>(F.lds, F.tid, S, E);
        } if (IN(pb + 1)) SEAM(pb + 1);
        if (IN(pb + 2)) { REPLOOP(pb + 2) {
#ifndef NO_ML
            { PHASE_ENV();
#pragma unroll 1
              for (int u = F.bid; u < 256 * REP_ML; u += F.G) { Frame Fu = F; { int t_ = F.tid; asm volatile("" : "+v"(t_)); Fu.tid = t_; Fu.lane = t_ & 63; Fu.wave = __builtin_amdgcn_readfirstlane(t_ >> 6); }
                mlA_unit(Fu, u & 255, (const bf16_t*)(ws + WS_PROJ), (const float*)(ws + WS_GATES), (bf16_t*)(ws + WS_HF), (bf16_t*)(ws + WS_HB), (float*)(ws + WS_SCAL), (float*)(ws + WS_U), (float*)(ws + WS_UN), (float*)(ws + WS_AA)); } }
#endif
#ifndef NO_AT
            { PHASE_ENV();
#pragma unroll 1
              for (int u = F.bid; u < 256 * REP_AT; u += F.G) { Frame Fu = F; { int t_ = F.tid; asm volatile("" : "+v"(t_)); Fu.tid = t_; Fu.lane = t_ & 63; Fu.wave = __builtin_amdgcn_readfirstlane(t_ >> 6); }
                attn_unit(Fu, u & 255, (const bf16_t*)(ws + WS_PROJ), (const float*)(ws + WS_ROPEC), (const float*)(ws + WS_ROPES), ap->in[6] + l * 128, ap->in[7] + l * 128, ap->in[8] + l * 8, (bf16_t*)(ws + WS_MIX)); } }
#endif
            }
            SEAM(pb + 2);
        }
        if (IN(pb + 3)) REPLOOP(pb + 3) { PHASE_ENV();
            const int ngemm = (F.G >= 256) ? 128 : 0;
            if (F.bid < ngemm || ngemm == 0) { pg8::SchedPlain<D, false> S{(const bf16_t*)(ws + WS_H8), (const bf16_t*)((const unsigned char*)(ws + WS_WMO8) + (size_t)l * 1024 * D), MTOK / 256, 1024 / 256, ngemm ? ngemm : F.G, F.bid};
                pg8::EpiStoreBf16 E{(bf16_t*)(ws + WS_PROJ) + INWA, INWG, 1.0f / pg8::WSC_UP};
                pg8::gemm_phase<D, true>(F.lds, F.tid, S, E); }
            if (F.bid >= ngemm) { Frame Fb = F; Fb.bid = F.bid - ngemm; Fb.G = F.G - ngemm;
                mlB_phase(Fb, (const float*)(ws + WS_U), (const float*)(ws + WS_UN), (const float*)(ws + WS_AA), (bf16_t*)(ws + WS_CPREV), (float*)(ws + WS_NPREV)); }
        } if (IN(pb + 3)) SEAM(pb + 3);
        if (IN(pb + 4)) REPLOOP(pb + 4) { PHASE_ENV();
#pragma unroll 1
            for (int u = F.bid; u < 256; u += F.G) { Frame Fu = F; { int t_ = F.tid; asm volatile("" : "+v"(t_)); Fu.tid = t_; Fu.lane = t_ & 63; Fu.wave = __builtin_amdgcn_readfirstlane(t_ >> 6); }
                mlC_unit(Fu, u, (const bf16_t*)(ws + WS_PROJ), (const bf16_t*)(ws + WS_HF), (const bf16_t*)(ws + WS_HB), (const float*)(ws + WS_SCAL), (const bf16_t*)(ws + WS_CPREV), (const float*)(ws + WS_NPREV), ap->in[9] + l * 1024, (bf16_t*)(ws + WS_MIX)); } } if (IN(pb + 4)) SEAM(pb + 4);
        if (IN(pb + 5)) REPLOOP(pb + 5) { PHASE_ENV();
            const float* MOD = (const float*)(ws + WS_MOD) + (size_t)l * NB * 6 * D;
            pg8::SchedPlain<2 * D> S{(const bf16_t*)(ws + WS_MIX), (const bf16_t*)(ws + WS_WOUT) + (size_t)l * D * D, MTOK / 256, D / 256, F.G, F.bid};
            if (l == 0) { pg8::EpiResidual<false> E{ap->in[0], (bf16_t*)(ws + WS_X1), MOD + 2 * D}; pg8::gemm_phase<2 * D, false>(F.lds, F.tid, S, E); }
            else { pg8::EpiResidual<true> E{ws + WS_X2, (bf16_t*)(ws + WS_X1), MOD + 2 * D}; pg8::gemm_phase<2 * D, false>(F.lds, F.tid, S, E); }
        } if (IN(pb + 5)) SEAM(pb + 5);
        if (IN(pb + 6)) REPLOOP(pb + 6) { PHASE_ENV();
            const float* MOD = (const float*)(ws + WS_MOD) + (size_t)l * NB * 6 * D;
            norm_phase<1, true>(F, ws + WS_X1, MOD + 3 * D, MOD + 4 * D, (const bf16_t*)(ws + WS_W16) + (size_t)(l * 2 + 1) * 16 * D, nullptr, nullptr, (unsigned char*)(ws + WS_H8), (float*)(ws + WS_AFF)); } if (IN(pb + 6)) SEAM(pb + 6);
        if (IN(pb + 7)) REPLOOP(pb + 7) { PHASE_ENV();
            LAS int* tbl = (LAS int*)(F.lds + LDS_TBL);
            for (int i0 = 0; i0 < 8; i0 += 2) { pg8::Unit u0, u1; const bool h0 = pg8::moe_unit(F.G, F.bid, i0, u0), h1 = pg8::moe_unit(F.G, F.bid, i0 + 1, u1);
                if (!h0) break;
                const int bb[2] = {u0.pm / NE, h1 ? u1.pm / NE : 0}, ee[2] = {u0.aux, h1 ? u1.aux : 0}; const bool pub[2] = {u0.pn == 0, h1 && u1.pn == 0};
                select_pair(F, h1 ? 2 : 1, bb, ee, pub, (const float*)(ws + WS_AFF), tbl + i0 * 256, (LAS unsigned*)(F.lds + LDS_MISC + 64), (float*)(ws + WS_GATEV), (int*)(ws + WS_SLOT)); }
            pg8::SchedMoeUp S{(const unsigned char*)(ws + WS_H8), (const unsigned char*)(ws + WS_WGU) + (size_t)l * NE * 2 * FF * D, tbl, F.G, F.bid}; pg8::EpiSwiGLU E{(unsigned char*)(ws + WS_HID)};
            pg8::gemm_phase<D, true>(F.lds, F.tid, S, E); } if (IN(pb + 7)) SEAM(pb + 7);
        if (IN(pb + 8)) REPLOOP(pb + 8) { PHASE_ENV();
            pg8::SchedMoeDown S{(const unsigned char*)(ws + WS_HID), (const unsigned char*)(ws + WS_WD) + (size_t)l * NE * D * FF, F.G, F.bid}; pg8::EpiGated E{(bf16_t*)(ws + WS_YE), (const float*)(ws + WS_GATEV)};
            pg8::gemm_phase<FF, true>(F.lds, F.tid, S, E); } if (IN(pb + 8)) SEAM(pb + 8);
        if (IN(pb + 9)) REPLOOP(pb + 9) { PHASE_ENV();
            const float* MOD = (const float*)(ws + WS_MOD) + (size_t)l * NB * 6 * D;
            if (l == DEPTH - 1) combine_phase<false>(F, (const bf16_t*)(ws + WS_X1), MOD + 5 * D, (const int*)(ws + WS_SLOT), (const bf16_t*)(ws + WS_YE), ap->out);
            else combine_phase<true>(F, (const bf16_t*)(ws + WS_X1), MOD + 5 * D, (const int*)(ws + WS_SLOT), (const bf16_t*)(ws + WS_YE), ws + WS_X2);
        } if (IN(pb + 9)) SEAM(pb + 9);
    }
#undef IN
#undef SEAM
}

extern "C" void kernel_launch(void* const* d_in, const int* in_sizes, int n_in, void* d_out, int out_size, void* d_ws, size_t ws_size, hipStream_t stream) {
    static int grid = 0;
    if (grid == 0) {
        if (n_in != 15 || out_size != MTOK * D || ws_size < WS_END) { fprintf(stderr, "kernel_launch: unexpected shapes (n_in %d out %d ws %zu need %zu)\n", n_in, out_size, ws_size, (size_t)WS_END); grid = -1; return; }
        int dev = 0, cus = 0, per_cu = 0;
        if (hipGetDevice(&dev) != hipSuccess || hipDeviceGetAttribute(&cus, hipDeviceAttributeMultiprocessorCount, dev) != hipSuccess) { grid = -1; return; }
        if (hipFuncSetAttribute((const void*)hymba_fwd, hipFuncAttributeMaxDynamicSharedMemorySize, LDS_BYTES) != hipSuccess) { fprintf(stderr, "kernel_launch: hipFuncSetAttribute failed\n"); grid = -1; return; }
        if (hipOccupancyMaxActiveBlocksPerMultiprocessor(&per_cu, (const void*)hymba_fwd, NTHR, LDS_BYTES) != hipSuccess || per_cu < 1)
            fprintf(stderr, "kernel_launch: occupancy query reports %d workgroups per CU\n", per_cu);
        (void)hipGetLastError();
        grid = cus;
    }
    if (grid < 0) return;
    if (hipMemsetAsync((char*)d_ws + WS_CTL, 0, WS_ZERO_END, stream) != hipSuccess) { fprintf(stderr, "kernel_launch: memset failed\n"); return; }
    Args a{};
    for (int i = 0; i < 15; ++i) a.in[i] = (const float*)d_in[i];
    a.out = (float*)d_out; a.ws = (unsigned char*)d_ws;
#if MK_SPLIT
    for (int p = 0; p < N_PHASES; ++p) { a.ph_lo = p; a.ph_hi = p + 1; hipLaunchKernelGGL(hymba_fwd, dim3(grid), dim3(NTHR), LDS_BYTES, stream, a); }
#else
    a.ph_lo = 0; a.ph_hi = N_PHASES; hipLaunchKernelGGL(hymba_fwd, dim3(grid), dim3(NTHR), LDS_BYTES, stream, a);
#endif
    const hipError_t le = hipPeekAtLastError();
    if (le != hipSuccess) fprintf(stderr, "kernel_launch: launch failed: %s\n", hipGetErrorName(le));
}
```

```cpp
#include <hip/hip_runtime.h>
#include <cstdio>
#include <cstdint>
#include <type_traits>

#ifndef MK_SPLIT
#define MK_SPLIT 0
#endif
#define REP_ML 1
#define REP_AT 1
#define REP_MLS 1
#define REP_ML1 1
#define REP_ML2 1
#define IN8 0

#define LAS __attribute__((address_space(3)))
#define DI __device__ __forceinline__
typedef unsigned short bf16_t;
typedef short bf16x8 __attribute__((ext_vector_type(8)));
typedef short s16x4 __attribute__((ext_vector_type(4)));
typedef float f32x2 __attribute__((ext_vector_type(2)));
typedef float f32x4 __attribute__((ext_vector_type(4)));
typedef float f32x16 __attribute__((ext_vector_type(16)));
typedef unsigned u32x2 __attribute__((ext_vector_type(2)));
typedef unsigned u32x4 __attribute__((ext_vector_type(4)));
typedef __bf16 bfv2 __attribute__((ext_vector_type(2)));

constexpr int D = 2048, NB = 4, SEQ = 2048, MTOK = NB * SEQ, DEPTH = 2;
constexpr int INW = 4624, INWG = 4608, INWA = 3584;
constexpr int C_AQ = 0, C_AK = 1024, C_AV = 1280, C_MQ = 1536, C_MK = 2048, C_MV = 2560, C_MO = 3584, C_MG = 4608;
constexpr int NE = 16, FF = 1024, CAP = 256;
constexpr float EPS = 1e-6f;
constexpr int NWAVES = 8, NTHR = 512;

constexpr size_t al256(size_t x) { return (x + 255) & ~(size_t)255; }
constexpr size_t WS_CTL = 0;
constexpr size_t WS_MOD = 65536;
constexpr size_t MOD_BYTES = (size_t)DEPTH * NB * 6 * D * 4;
constexpr size_t WS_ZERO_END = 32768;
constexpr size_t WS_MOD_END = al256(WS_MOD + MOD_BYTES);
constexpr size_t WS_ROPEC = WS_MOD_END;
constexpr size_t WS_ROPES = WS_ROPEC + (size_t)SEQ * 64 * 4;
constexpr size_t WS_GATES = WS_ROPES + (size_t)SEQ * 64 * 4;
constexpr size_t WS_AFF = WS_GATES + (size_t)MTOK * 16 * 4;
constexpr size_t WS_SLOT = WS_AFF + (size_t)MTOK * 16 * 4;
constexpr size_t WS_IDX = WS_SLOT + (size_t)MTOK * 16 * 4;
constexpr size_t WS_GATEV = WS_IDX + (size_t)NB * NE * CAP * 4;
constexpr size_t WS_WIN = WS_GATEV + (size_t)NB * NE * CAP * 4;
constexpr size_t WS_WOUT = WS_WIN + (size_t)DEPTH * INWG * D * 2;
constexpr size_t WS_WGU = WS_WOUT + (size_t)DEPTH * D * D * 2;
constexpr size_t WS_WD = WS_WGU + (size_t)DEPTH * NE * 2 * FF * D * 2;
constexpr size_t WS_H = WS_WD + (size_t)DEPTH * NE * D * FF * 2;
constexpr size_t WS_PROJ = WS_H + (size_t)MTOK * D * 2;
constexpr size_t WS_MIX = WS_PROJ + (size_t)MTOK * INWG * 2;
constexpr size_t WS_HF = WS_MIX + (size_t)MTOK * D * 2;
constexpr size_t WS_HB = WS_HF + (size_t)MTOK * 1024 * 4;
constexpr size_t WS_X1 = WS_HB + (size_t)MTOK * 1024 * 4;
constexpr size_t WS_X2 = WS_X1 + (size_t)MTOK * D * 4;
constexpr size_t WS_HID = WS_X2 + (size_t)MTOK * D * 4;
constexpr size_t WS_YE = WS_HID + (size_t)NB * NE * CAP * FF * 2;
constexpr size_t WS_SCAL = WS_YE + (size_t)NB * NE * CAP * D * 2;
constexpr size_t WS_U = WS_SCAL + (size_t)2 * 3 * NB * 4 * SEQ * 4;
constexpr size_t WS_UN = WS_U + (size_t)32 * 8 * 128 * 256 * 4;
constexpr size_t WS_AA = WS_UN + (size_t)32 * 8 * 128 * 4;
constexpr size_t WS_CPREV = WS_AA + 4096;
constexpr size_t WS_NPREV = WS_CPREV + (size_t)32 * 7 * 128 * 256 * 2;
constexpr size_t WS_W16 = WS_NPREV + (size_t)32 * 7 * 128 * 4;
constexpr size_t WS_H8 = WS_W16 + (size_t)DEPTH * 2 * 16 * D * 2;
constexpr size_t WS_WMO8 = WS_H8 + (size_t)MTOK * D;
constexpr size_t WS_END = WS_WMO8 + (size_t)DEPTH * 1024 * D;

constexpr int LDS_STAGE = 131072;
constexpr int LDS_TBL = LDS_STAGE;
constexpr int LDS_MISC = LDS_STAGE + 8192;
constexpr int LDS_BYTES = LDS_STAGE + 8192 + 1024;

DI float bf2f(unsigned b16) { return __uint_as_float(b16 << 16); }
DI unsigned pk2(float lo, float hi) { bfv2 r = __builtin_convertvector((f32x2){lo, hi}, bfv2); return __builtin_bit_cast(unsigned, r); }
DI float shx(float v, int o, int lane) { return __int_as_float(__builtin_amdgcn_ds_bpermute((lane ^ o) << 2, __float_as_int(v))); }
DI float shup(float v, int o, int lane) { const int src = lane >= o ? lane - o : lane; return __int_as_float(__builtin_amdgcn_ds_bpermute(src << 2, __float_as_int(v))); }
DI u32x4 widen_pair(u32x2 a, u32x2 b) {
    const auto r0 = __builtin_amdgcn_permlane32_swap(a.x, b.x, false, false); const auto r1 = __builtin_amdgcn_permlane32_swap(a.y, b.y, false, false);
    return (u32x4){r0[0], r1[0], r0[1], r1[1]};
}
DI void narrow_pair(u32x4 w, u32x2& a, u32x2& b) {
    const auto r0 = __builtin_amdgcn_permlane32_swap(w.x, w.z, false, false); const auto r1 = __builtin_amdgcn_permlane32_swap(w.y, w.w, false, false);
    a = (u32x2){r0[0], r1[0]}; b = (u32x2){r0[1], r1[1]};
}
DI float rdlane(float v, int l) { return __int_as_float(__builtin_amdgcn_readlane(__float_as_int(v), l)); }
DI float wave_sum(float v, int lane) {
#pragma unroll
    for (int o = 1; o < 64; o <<= 1) v += shx(v, o, lane);
    return v;
}
DI void unpack8(const u32x4 raw, float (&x)[8]) {
#pragma unroll
    for (int i = 0; i < 4; ++i) { x[2 * i] = __uint_as_float(raw[i] << 16); x[2 * i + 1] = __uint_as_float(raw[i] & 0xffff0000u); }
}
DI u32x4 pack8(const float (&x)[8]) { u32x4 w; w.x = pk2(x[0], x[1]); w.y = pk2(x[2], x[3]); w.z = pk2(x[4], x[5]); w.w = pk2(x[6], x[7]); return w; }
DI float fast_exp2(float x) { return __builtin_amdgcn_exp2f(x); }
DI float fast_rcp(float x) { return __builtin_amdgcn_rcpf(x); }
#define LDS_WAIT() asm volatile("s_waitcnt lgkmcnt(0)" ::: "memory")
#define VM_WAIT() asm volatile("s_waitcnt vmcnt(0)" ::: "memory")
constexpr float LOG2E = 1.4426950408889634f;

#define XB_TMO      128
#define XB_XCNT(j)  (256  + 64 * (j))
#define XB_XSUB(j)  (1280 + 64 * (j))
#define XB_XGEN(j)  (2304 + 64 * (j))
#define XB_TOP      3328
#define XB_TOPGEN   3392
#define XCD_BAR_WORDS 3456
#define XB_SPIN_CAP (1u << 18)

DI unsigned xb_ld(unsigned* p)              { return __hip_atomic_load(p, __ATOMIC_RELAXED, __HIP_MEMORY_SCOPE_AGENT); }
DI unsigned xb_add(unsigned* p, unsigned v) { return __hip_atomic_fetch_add(p, v, __ATOMIC_RELAXED, __HIP_MEMORY_SCOPE_AGENT); }
DI unsigned xb_xcc_id() { return (unsigned)__builtin_amdgcn_s_getreg((3 << 11) | 20) & 0xFu; }
#define XB_SPIN(cond, bar) do { unsigned _sp = 0; while (cond) { __builtin_amdgcn_s_sleep(1); \
    if ((++_sp & 255u) == 0u) { if (xb_ld(&(bar)[XB_TMO])) break; if (_sp > XB_SPIN_CAP) { atomicAdd(&(bar)[XB_TMO], 1u); break; } } } } while (0)

struct XcdBarrier { unsigned* bar; unsigned x; volatile LAS unsigned* st; };

DI XcdBarrier xcd_barrier_post(unsigned* bar, volatile LAS unsigned* st) {
    XcdBarrier b; b.bar = bar; b.x = xb_xcc_id(); b.st = st;
    if (threadIdx.x == 0) (void)xb_add(&bar[XB_XCNT(b.x)], 1u);
    return b;
}
DI void xcd_barrier_complete(unsigned* bar, unsigned x, unsigned& nloc, unsigned& nx) {
    const unsigned G = gridDim.x * gridDim.y * gridDim.z;
    unsigned sum, cnt, sp = 0u;
    for (;;) {
        sum = 0u; cnt = 0u;
#pragma unroll 1
        for (unsigned j = 0; j < 16; ++j) { const unsigned c = xb_ld(&bar[XB_XCNT(j)]); sum += c; cnt += (c > 0u) ? 1u : 0u; }
        if (sum == G) break;
        __builtin_amdgcn_s_sleep(1);
        if ((++sp & 255u) == 0u) { if (xb_ld(&bar[XB_TMO])) break; if (sp > XB_SPIN_CAP) { atomicAdd(&bar[XB_TMO], 1u); break; } }
    }
    const unsigned mine = xb_ld(&bar[XB_XCNT(x)]);
    nloc = mine > 0u ? mine : 1u; nx = cnt > 0u ? cnt : 1u;
}
DI void xcd_barrier(const XcdBarrier& b) {
    asm volatile("s_waitcnt vmcnt(0)" ::: "memory");
    __syncthreads();
    if (threadIdx.x == 0) {
        unsigned* bar = b.bar; unsigned bx = b.x;
        asm volatile("" : "+s"(bar), "+s"(bx));
        __builtin_amdgcn_s_waitcnt(0);
        unsigned nloc = b.st[0], nx = b.st[1];
        if (nloc == 0u) { xcd_barrier_complete(bar, bx, nloc, nx); b.st[0] = nloc; b.st[1] = nx; }
        const unsigned old = xb_add(&bar[XB_XSUB(bx)], 1u);
        const unsigned gen = old / nloc;
        if (old + 1u == (gen + 1u) * nloc) {
            __builtin_amdgcn_fence(__ATOMIC_RELEASE, "agent");
            asm volatile("s_waitcnt vmcnt(0)" ::: "memory");
            const unsigned og = xb_add(&bar[XB_TOP], 1u);
            const unsigned tg = og / nx;
            if (og + 1u == (tg + 1u) * nx) xb_add(&bar[XB_TOPGEN], 1u);
            else XB_SPIN(xb_ld(&bar[XB_TOPGEN]) == tg, bar);
            __builtin_amdgcn_fence(__ATOMIC_ACQUIRE, "agent");
            xb_add(&bar[XB_XGEN(bx)], 1u);
            asm volatile("s_waitcnt vmcnt(0)" ::: "memory");
        } else {
            XB_SPIN(xb_ld(&bar[XB_XGEN(bx)]) == gen, bar);
            __builtin_amdgcn_fence(__ATOMIC_ACQUIRE, "agent");
            asm volatile("s_waitcnt vmcnt(0)" ::: "memory");
        }
    }
    __syncthreads();
}

namespace pg8 {
constexpr int BM = 256, BK = 64, HALF = 128, HTB = HALF * BK * 2, STAGE_BYTES = 8 * HTB, NXCD = 8, WGM = 8;
DI int lds_byte(int r, int c) { const int st = (r >> 4) * 2 + (c >> 5), rr = r & 15, cc = c & 31, ob = rr * 64 + cc * 2; return st * 1024 + (ob ^ (((ob >> 9) & 1) << 5)); }
DI void stage_rc(int b, int& R, int& C) { const int st = b / 1024, sb = b % 1024, swz = sb ^ (((sb >> 9) & 1) << 5); R = (st >> 1) * 16 + swz / 64; C = (st & 1) * 32 + (swz % 64) / 2; }
DI int perm32(int rho) { const int n = rho >> 4, i = rho & 15; return 8 * (i >> 2) + 4 * n + (i & 3); }
struct Unit { int pm, pn, aux; };

typedef int i32x8 __attribute__((ext_vector_type(8)));
typedef int i32x4v __attribute__((ext_vector_type(4)));
template <int KB, bool FP8, class Epi, class Sched>
DI void gemm_phase(LAS unsigned char* lds, const int tid, const Sched& S, const Epi& E) {
    const int wid = __builtin_amdgcn_readfirstlane(tid >> 6), lane = tid & 63, wr = wid >> 2, wc = wid & 3, fr = lane & 15, fq = lane >> 4;
    constexpr int nt = KB / 128;
    int R[2], C[2]; unsigned voffB[2];
#pragma unroll
    for (int i = 0; i < 2; ++i) { stage_rc(tid * 16 + i * 8192, R[i], C[i]); const int Rb = Epi::PERM ? ((R[i] & ~31) + perm32(R[i] & 31)) : R[i]; voffB[i] = (unsigned)(Rb * KB) + (unsigned)C[i] * 2u; }
    constexpr size_t kstep = (size_t)(BK * 2);
    constexpr size_t hstep = (size_t)HALF * KB;
    const unsigned ldsw = (unsigned)wid * 1024u;
    const int aoff = lds_byte(wr * 64 + fr, fq * 8), boff = lds_byte(wc * 32 + fr, fq * 8);
#define PG8_SA(b, h) (((b) * 2 + (h)) * HTB)
#define PG8_SB(b, h) ((4 + (b) * 2 + (h)) * HTB)
#define PG8_STAGE(bufoff, gbase, voff) do { _Pragma("unroll") for (int _i = 0; _i < 2; ++_i) \
        __builtin_amdgcn_global_load_lds((const unsigned*)((const char*)(gbase) + (voff)[_i]), (LAS unsigned*)(lds + (bufoff) + ldsw + _i * 8192), 16, 0, 0); } while (0)
#define PG8_LDA(dst, b, h) do { _Pragma("unroll") for (int m = 0; m < 4; ++m) _Pragma("unroll") for (int k = 0; k < 2; ++k) dst[m][k] = *(const LAS bf16x8*)(lds + PG8_SA(b, h) + aoff + m * 2048 + k * 1024); } while (0)
#define PG8_LDB(dst, b, h) do { _Pragma("unroll") for (int n = 0; n < 2; ++n) _Pragma("unroll") for (int k = 0; k < 2; ++k) dst[n][k] = *(const LAS bf16x8*)(lds + PG8_SB(b, h) + boff + n * 2048 + k * 1024); } while (0)
#define PG8_MMA(ai, bj, At, Bt) do { if constexpr (Sched::PRIO) __builtin_amdgcn_s_setprio(1); _Pragma("unroll") for (int m = 0; m < 4; ++m) _Pragma("unroll") for (int n = 0; n < 2; ++n) { \
        if constexpr (FP8) { const i32x8 a8 = __builtin_shufflevector(__builtin_bit_cast(i32x4v, Bt[n][0]), __builtin_bit_cast(i32x4v, Bt[n][1]), 0, 1, 2, 3, 4, 5, 6, 7), \
                                         b8 = __builtin_shufflevector(__builtin_bit_cast(i32x4v, At[m][0]), __builtin_bit_cast(i32x4v, At[m][1]), 0, 1, 2, 3, 4, 5, 6, 7); \
            acc[ai][bj][m][n] = __builtin_amdgcn_mfma_scale_f32_16x16x128_f8f6f4(a8, b8, acc[ai][bj][m][n], 0, 0, 0, 0x7f7f7f7f, 0, 0x7f7f7f7f); } \
        else { _Pragma("unroll") for (int k = 0; k < 2; ++k) acc[ai][bj][m][n] = __builtin_amdgcn_mfma_f32_16x16x32_bf16(Bt[n][k], At[m][k], acc[ai][bj][m][n], 0, 0, 0); } } \
        if constexpr (Sched::PRIO) __builtin_amdgcn_s_setprio(0); } while (0)
#define PG8_WAIT_V(n) asm volatile("s_waitcnt vmcnt(" #n ")" ::: "memory")
#define PG8_WAIT_L(n) asm volatile("s_waitcnt lgkmcnt(" #n ")" ::: "memory")
#define PG8_BAR __builtin_amdgcn_s_barrier()
#define PG8_SCHED __builtin_amdgcn_sched_barrier(0)
    Unit cur, nxt; int ui = 0;
    if (!S.next(0, cur)) return;
    float z0_ = 0.f; asm volatile("" : "+v"(z0_));
    const f32x4 ZERO4 = (f32x4){z0_, z0_, z0_, z0_};
    f32x4 acc[2][2][4][2];
#pragma unroll
    for (int a = 0; a < 2; ++a)
#pragma unroll
        for (int b = 0; b < 2; ++b)
#pragma unroll
            for (int m = 0; m < 4; ++m)
#pragma unroll
                for (int n = 0; n < 2; ++n) acc[a][b][m][n] = ZERO4;
    bf16x8 At[4][2], B0[2][2], B1[2][2];
    unsigned vA0[2], vA1[2], vN0[2], vN1[2];
    S.a_off(cur, 0, R, C, vA0, vA1);
    const char* cA = S.a_ptr(cur); const char* cB = S.b_ptr(cur);
    PG8_STAGE(PG8_SB(0, 0), cB, voffB); PG8_STAGE(PG8_SA(0, 0), cA, vA0); PG8_STAGE(PG8_SB(0, 1), cB + hstep, voffB); PG8_STAGE(PG8_SA(0, 1), cA, vA1);
    if (wr == 1) PG8_BAR;
    PG8_WAIT_V(4); PG8_BAR;
    PG8_STAGE(PG8_SB(1, 0), cB + kstep, voffB); PG8_STAGE(PG8_SA(1, 0), cA + kstep, vA0); PG8_STAGE(PG8_SB(1, 1), cB + hstep + kstep, voffB);
    PG8_WAIT_V(6); PG8_BAR;
    for (;;) {
        const bool has_next = S.next(ui + 1, nxt);
        const char* nA = has_next ? S.a_ptr(nxt) : cA; const char* nB = has_next ? S.b_ptr(nxt) : cB;
        if constexpr (Sched::GATHER) { if (has_next) S.a_off(nxt, ui + 1, R, C, vN0, vN1); else { vN0[0] = vA0[0]; vN0[1] = vA0[1]; vN1[0] = vA1[0]; vN1[1] = vA1[1]; } }
#pragma unroll 1
        for (int t = 0; t < nt; t += 2) {
            const bool last = (t == nt - 2);
            const char* a1 = cA + (size_t)(t + 1) * kstep;
            const char* a2 = last ? nA : cA + (size_t)(t + 2) * kstep; const char* b2 = last ? nB : cB + (size_t)(t + 2) * kstep;
            const char* a3 = a2 + kstep; const char* b3 = b2 + kstep;
            PG8_LDB(B0, 0, 0); PG8_SCHED; PG8_LDA(At, 0, 0); PG8_STAGE(PG8_SA(1, 1), a1, vA1);
            if constexpr (Sched::GATHER) { if (last) { vA0[0] = vN0[0]; vA0[1] = vN0[1]; vA1[0] = vN1[0]; vA1[1] = vN1[1]; } }
            PG8_WAIT_L(8); PG8_BAR; PG8_WAIT_L(0); PG8_MMA(0, 0, At, B0); PG8_BAR; PG8_SCHED;
            PG8_LDB(B1, 0, 1); PG8_STAGE(PG8_SB(0, 0), b2, voffB);
            PG8_BAR; PG8_WAIT_L(0); PG8_MMA(0, 1, At, B1); PG8_BAR;
            PG8_LDA(At, 0, 1); PG8_STAGE(PG8_SA(0, 0), a2, vA0);
            PG8_BAR; PG8_WAIT_L(0); PG8_MMA(1, 0, At, B0); PG8_BAR; PG8_SCHED;
            PG8_STAGE(PG8_SB(0, 1), b2 + hstep, voffB);
            PG8_WAIT_V(6); PG8_BAR; PG8_MMA(1, 1, At, B1); PG8_BAR;
            PG8_LDB(B0, 1, 0); PG8_SCHED; PG8_LDA(At, 1, 0); PG8_STAGE(PG8_SA(0, 1), a2, vA1);
            PG8_WAIT_L(8); PG8_BAR; PG8_WAIT_L(0); PG8_MMA(0, 0, At, B0); PG8_BAR; PG8_SCHED;
            PG8_LDB(B1, 1, 1); PG8_STAGE(PG8_SB(1, 0), b3, voffB);
            PG8_BAR; PG8_WAIT_L(0); PG8_MMA(0, 1, At, B1); PG8_BAR;
            PG8_LDA(At, 1, 1); PG8_STAGE(PG8_SA(1, 0), a3, vA0);
            PG8_BAR; PG8_WAIT_L(0); PG8_MMA(1, 0, At, B0); PG8_BAR; PG8_SCHED;
            PG8_STAGE(PG8_SB(1, 1), b3 + hstep, voffB);
            PG8_WAIT_V(6); PG8_BAR; PG8_MMA(1, 1, At, B1); PG8_BAR;
        }
        E(acc, cur, wr, wc, fr, fq);
        if (!has_next) break;
#pragma unroll
        for (int a = 0; a < 2; ++a)
#pragma unroll
            for (int b = 0; b < 2; ++b)
#pragma unroll
                for (int m = 0; m < 4; ++m)
#pragma unroll
                    for (int n = 0; n < 2; ++n) acc[a][b][m][n] = ZERO4;
        cur = nxt; cA = nA; cB = nB; ++ui;
    }
    PG8_WAIT_V(0);
    if (wr == 0) PG8_BAR;
    PG8_BAR;
#undef PG8_SA
#undef PG8_SB
#undef PG8_STAGE
#undef PG8_LDA
#undef PG8_LDB
#undef PG8_MMA
#undef PG8_WAIT_V
#undef PG8_WAIT_L
#undef PG8_BAR
#undef PG8_SCHED
}

DI bool static_unit(int nM, int nN, int G, int c, int i, int& pm, int& pn) {
    const int nwg = nM * nN; const long L = (long)i * G + c; if (L >= nwg) return false;
    int wgid = (int)L; { const int q = nwg / NXCD, r = nwg % NXCD, xcd = wgid % NXCD, off = wgid / NXCD; wgid = (xcd < r ? xcd * (q + 1) : r * (q + 1) + (xcd - r) * q) + off; }
    const int nig = WGM * nN, gid = wgid / nig, fm = gid * WGM, gsz = (nM - fm) < WGM ? (nM - fm) : WGM;
    pm = fm + ((wgid % nig) % gsz); pn = (wgid % nig) / gsz; return true;
}
template <int KB, bool PRIO_ = true> struct SchedPlain {
    static constexpr bool GATHER = false, PRIO = PRIO_;
    const bf16_t* A; const bf16_t* Bt; int nM, nN, G, c;
    DI bool next(int i, Unit& u) const { u.aux = 0; return static_unit(nM, nN, G, c, i, u.pm, u.pn); }
    DI const char* a_ptr(const Unit& u) const { return (const char*)A + (size_t)u.pm * BM * KB; }
    DI const char* b_ptr(const Unit& u) const { return (const char*)Bt + (size_t)u.pn * BM * KB; }
    DI void a_off(const Unit&, int, const int (&R)[2], const int (&C)[2], unsigned (&v0)[2], unsigned (&v1)[2]) const {
#pragma unroll
        for (int i = 0; i < 2; ++i) { v0[i] = (unsigned)(R[i] * KB + C[i] * 2); v1[i] = (unsigned)((R[i] + HALF) * KB + C[i] * 2); }
    }
};
DI bool moe_unit(int G, int c, int i, Unit& u) {
    const int L = i * G + c; if (L >= NB * NE * 8) return false;
    const int wgid = (L % NXCD) * (NB * NE * 8 / NXCD) + L / NXCD;
    const int e = wgid >> 5, ntile = (wgid >> 2) & 7, b = wgid & 3;
    u.pm = b * NE + e; u.pn = ntile; u.aux = e; return true;
}
struct SchedMoeUp {
    static constexpr bool GATHER = true, PRIO = true;
    const unsigned char* Hm; const unsigned char* W; const LAS int* tbl; int G, c;
    DI bool next(int i, Unit& u) const { return moe_unit(G, c, i, u); }
    DI const char* a_ptr(const Unit&) const { return (const char*)Hm; }
    DI const char* b_ptr(const Unit& u) const { return (const char*)W + ((size_t)u.aux * 2 * FF + (size_t)u.pn * BM) * D; }
    DI void a_off(const Unit&, int i, const int (&R)[2], const int (&C)[2], unsigned (&v0)[2], unsigned (&v1)[2]) const {
#pragma unroll
        for (int j = 0; j < 2; ++j) { const int r0 = tbl[i * 256 + R[j]], r1 = tbl[i * 256 + HALF + R[j]];
            v0[j] = (unsigned)(r0 * D + C[j] * 2); v1[j] = (unsigned)(r1 * D + C[j] * 2); }
    }
};
struct SchedMoeDown {
    static constexpr bool GATHER = false, PRIO = false;
    const unsigned char* Hid; const unsigned char* W; int G, c;
    DI bool next(int i, Unit& u) const { return moe_unit(G, c, i, u); }
    DI const char* a_ptr(const Unit& u) const { return (const char*)Hid + (size_t)u.pm * BM * FF; }
    DI const char* b_ptr(const Unit& u) const { return (const char*)W + ((size_t)u.aux * D + (size_t)u.pn * BM) * FF; }
    DI void a_off(const Unit&, int, const int (&R)[2], const int (&C)[2], unsigned (&v0)[2], unsigned (&v1)[2]) const {
#pragma unroll
        for (int i = 0; i < 2; ++i) { v0[i] = (unsigned)(R[i] * FF + C[i] * 2); v1[i] = (unsigned)((R[i] + HALF) * FF + C[i] * 2); }
    }
};

DI unsigned pk4_fp8(float a, float b, float c, float d) { int p = 0; p = __builtin_amdgcn_cvt_pk_fp8_f32(a, b, p, false); p = __builtin_amdgcn_cvt_pk_fp8_f32(c, d, p, true); return (unsigned)p; }
constexpr float WSC_UP = 64.0f, WSC_DOWN = 32.0f;
DI unsigned cvt_pk_bf16(float lo, float hi) { unsigned r; asm volatile("v_cvt_pk_bf16_f32 %0, %1, %2" : "=v"(r) : "v"(lo), "v"(hi)); return r; }

struct EpiStoreBf16 {
    static constexpr bool PERM = true;
    bf16_t* O; int ldc; float scale;
    DI void operator()(const f32x4 (&acc)[2][2][4][2], const Unit& u, int wr, int wc, int fr, int fq) const {
        const int row0 = u.pm * BM + wr * 64 + fr, col0 = u.pn * BM + wc * 32 + 8 * fq;
#pragma unroll
        for (int ai = 0; ai < 2; ++ai)
#pragma unroll
            for (int m = 0; m < 4; ++m) { bf16_t* rowp = O + (size_t)(row0 + ai * HALF + m * 16) * ldc + col0;
#pragma unroll
                for (int bj = 0; bj < 2; ++bj) { const f32x4 v0 = acc[ai][bj][m][0] * scale, v1 = acc[ai][bj][m][1] * scale;
                    u32x4 w; w.x = cvt_pk_bf16(v0[0], v0[1]); w.y = cvt_pk_bf16(v0[2], v0[3]); w.z = cvt_pk_bf16(v1[0], v1[1]); w.w = cvt_pk_bf16(v1[2], v1[3]);
                    *(u32x4*)(rowp + bj * HALF) = w; } }
    }
};
template <bool XBF> struct EpiResidual {
    static constexpr bool PERM = true;
    const void* Xin; bf16_t* Out; const float* g;
    DI void operator()(const f32x4 (&acc)[2][2][4][2], const Unit& u, int wr, int wc, int fr, int fq) const {
        const int row0 = u.pm * BM + wr * 64 + fr, col0 = u.pn * BM + wc * 32 + 8 * fq;
        const float* gb = g + (size_t)(u.pm / (SEQ / BM)) * 6 * D + col0;
        f32x4 gv[2][2];
#pragma unroll
        for (int bj = 0; bj < 2; ++bj)
#pragma unroll
            for (int n = 0; n < 2; ++n) gv[bj][n] = *(const f32x4*)(gb + bj * HALF + n * 4);
#pragma unroll
        for (int ai = 0; ai < 2; ++ai)
#pragma unroll
            for (int m = 0; m < 4; ++m) { const size_t ro = (size_t)(row0 + ai * HALF + m * 16) * D + col0;
#pragma unroll
                for (int bj = 0; bj < 2; ++bj) { float x8[8];
                    if (XBF) unpack8(*(const u32x4*)((const bf16_t*)Xin + ro + bj * HALF), x8);
                    else { const f32x4 xa = *(const f32x4*)((const float*)Xin + ro + bj * HALF), xb = *(const f32x4*)((const float*)Xin + ro + bj * HALF + 4);
                        x8[0] = xa[0]; x8[1] = xa[1]; x8[2] = xa[2]; x8[3] = xa[3]; x8[4] = xb[0]; x8[5] = xb[1]; x8[6] = xb[2]; x8[7] = xb[3]; }
#pragma unroll
                    for (int n = 0; n < 2; ++n)
#pragma unroll
                        for (int j = 0; j < 4; ++j) x8[n * 4 + j] += gv[bj][n][j] * acc[ai][bj][m][n][j];
                    u32x4 w; w.x = cvt_pk_bf16(x8[0], x8[1]); w.y = cvt_pk_bf16(x8[2], x8[3]); w.z = cvt_pk_bf16(x8[4], x8[5]); w.w = cvt_pk_bf16(x8[6], x8[7]);
                    *(u32x4*)(Out + ro + bj * HALF) = w; } }
    }
};
struct EpiSwiGLU {
    static constexpr bool PERM = true;
    unsigned char* Hid;
    DI void operator()(const f32x4 (&acc)[2][2][4][2], const Unit& u, int wr, int wc, int fr, int fq) const {
        const int row0 = u.pm * BM + wr * 64 + fr, col0 = u.pn * HALF + wc * 32 + 8 * fq;
#pragma unroll
        for (int ai = 0; ai < 2; ++ai)
#pragma unroll
            for (int m = 0; m < 4; ++m) { unsigned char* rowp = Hid + (size_t)(row0 + ai * HALF + m * 16) * FF + col0;
                float h[8];
#pragma unroll
                for (int n = 0; n < 2; ++n)
#pragma unroll
                    for (int j = 0; j < 4; ++j) { const float gg = acc[ai][0][m][n][j] * (1.0f / WSC_UP), uu = acc[ai][1][m][n][j] * (1.0f / WSC_UP);
                        h[n * 4 + j] = gg * fast_rcp(1.0f + fast_exp2(-gg * LOG2E)) * uu; }
                u32x2 w; w.x = pk4_fp8(h[0], h[1], h[2], h[3]); w.y = pk4_fp8(h[4], h[5], h[6], h[7]);
                *(u32x2*)rowp = w; }
    }
};
constexpr float YSC = 64.0f;
struct EpiGated {
    static constexpr bool PERM = true;
    unsigned char* O; const float* gate;
    DI void operator()(const f32x4 (&acc)[2][2][4][2], const Unit& u, int wr, int wc, int fr, int fq) const {
        const int row0 = u.pm * BM + wr * 64 + fr, col0 = u.pn * BM + wc * 32 + 8 * fq;
#pragma unroll
        for (int ai = 0; ai < 2; ++ai)
#pragma unroll
            for (int m = 0; m < 4; ++m) { const int row = row0 + ai * HALF + m * 16; const float gt = gate[row] * (YSC / WSC_DOWN); unsigned char* rowp = O + (size_t)row * D + col0;
#pragma unroll
                for (int bj = 0; bj < 2; ++bj) { const f32x4 v0 = acc[ai][bj][m][0] * gt, v1 = acc[ai][bj][m][1] * gt;
                    u32x2 w; w.x = pk4_fp8(v0[0], v0[1], v0[2], v0[3]); w.y = pk4_fp8(v1[0], v1[1], v1[2], v1[3]);
                    *(u32x2*)(rowp + bj * HALF) = w; } }
    }
};
}

struct Frame { LAS unsigned char* lds; int tid, lane, wave, G, bid; };
#define MFMA16(a, b, c) __builtin_amdgcn_mfma_f32_16x16x32_bf16((a), (b), (c), 0, 0, 0)
#define MFMA32(a, b, c) __builtin_amdgcn_mfma_f32_32x32x16_bf16((a), (b), (c), 0, 0, 0)


struct CvItem { const float* src; void* dst; int ldw, K, dst_row, k0, n0; float scale; bool fp8; };
DI void cv_load(const CvItem& it, f32x4 (&v)[16], int lane) {
    const float* src = it.src + (size_t)(it.k0 + (lane >> 3)) * it.ldw + it.n0 + 4 * (lane & 7);
#pragma unroll
    for (int i = 0; i < 16; ++i) v[i] = *(const f32x4*)(src + (size_t)(8 * i) * it.ldw);
}
DI void cv_store(const CvItem& it, const f32x4 (&v)[16], LAS float* scr, int lane) {
#pragma unroll
    for (int i = 0; i < 16; ++i) { LAS float* d = scr + (8 * i + (lane >> 3)) * 33 + 4 * (lane & 7); d[0] = v[i].x; d[1] = v[i].y; d[2] = v[i].z; d[3] = v[i].w; }
    LDS_WAIT();
    const int c = lane & 7; const float scale = it.scale;
#pragma unroll
    for (int j = 0; j < 4; ++j) { const int n = (lane >> 3) + 8 * j; const LAS float* s = scr + (16 * c) * 33 + n;
        float t[16];
#pragma unroll
        for (int i = 0; i < 16; ++i) t[i] = s[i * 33];
        if (it.fp8) { u32x4 o; o.x = pg8::pk4_fp8(t[0] * scale, t[1] * scale, t[2] * scale, t[3] * scale); o.y = pg8::pk4_fp8(t[4] * scale, t[5] * scale, t[6] * scale, t[7] * scale);
            o.z = pg8::pk4_fp8(t[8] * scale, t[9] * scale, t[10] * scale, t[11] * scale); o.w = pg8::pk4_fp8(t[12] * scale, t[13] * scale, t[14] * scale, t[15] * scale);
            *(u32x4*)((unsigned char*)it.dst + (size_t)(it.dst_row + n) * it.K + it.k0 + 16 * c) = o; }
        else { u32x4 o0, o1; o0.x = pk2(t[0], t[1]); o0.y = pk2(t[2], t[3]); o0.z = pk2(t[4], t[5]); o0.w = pk2(t[6], t[7]); o1.x = pk2(t[8], t[9]); o1.y = pk2(t[10], t[11]); o1.z = pk2(t[12], t[13]); o1.w = pk2(t[14], t[15]);
            bf16_t* d = (bf16_t*)it.dst + (size_t)(it.dst_row + n) * it.K + it.k0 + 16 * c; *(u32x4*)d = o0; *(u32x4*)(d + 8) = o1; } }
    LDS_WAIT();
}
struct Ptrs {
    const float *x, *c, *w_ada, *b_ada, *w_in, *b_gates, *q_gain, *k_gain, *sink, *m_gain, *w_out, *w_router, *w_gate, *w_up, *w_down;
    float* out; unsigned char* ws;
};
constexpr int CV_IN = (D / 128) * (INWG / 32), CV_OUT = (D / 128) * (D / 32), CV_GE = (D / 128) * (FF / 32), CV_G = NE * CV_GE, CV_DE = (FF / 128) * (D / 32), CV_D = NE * CV_DE;
constexpr int CV_PER_LAYER = CV_IN + CV_OUT + 2 * CV_G + CV_D, CV_TOTAL = DEPTH * CV_PER_LAYER;
constexpr int CV_DEFER = 0;
DI CvItem cv_decode(const Ptrs& P, int it) {
    unsigned char* ws = P.ws; CvItem c;
    const int l = it / CV_PER_LAYER; int r = it % CV_PER_LAYER;
    if (r < CV_IN) { const int kb = r / (INWG / 32), nb = r % (INWG / 32); c.src = P.w_in + (size_t)l * D * INW; c.ldw = INW; c.K = D; c.k0 = 128 * kb; c.n0 = 32 * nb;
        if (32 * nb < INWA) { c.dst = (bf16_t*)(ws + WS_WIN) + (size_t)l * INWG * D; c.dst_row = 32 * nb; c.scale = 1.0f; c.fp8 = false; }
        else { c.dst = (unsigned char*)(ws + WS_WMO8) + (size_t)l * 1024 * D; c.dst_row = 32 * nb - INWA; c.scale = pg8::WSC_UP; c.fp8 = true; }
        return c; }
    r -= CV_IN;
    if (r < CV_OUT) { const int kb = r / (D / 32), nb = r % (D / 32); c.src = P.w_out + (size_t)l * D * D; c.ldw = D; c.K = D; c.k0 = 128 * kb; c.n0 = 32 * nb;
        c.dst = (bf16_t*)(ws + WS_WOUT) + (size_t)l * D * D; c.dst_row = 32 * nb; c.scale = 1.0f; c.fp8 = false; return c; }
    r -= CV_OUT;
    if (r < 2 * CV_G) { const int up = r >= CV_G; if (up) r -= CV_G;
        const int e = r / CV_GE, q = r % CV_GE, kb = q / (FF / 32), nb = q % (FF / 32), n0 = 32 * nb;
        c.src = (up ? P.w_up : P.w_gate) + (size_t)(l * NE + e) * D * FF; c.ldw = FF; c.K = D; c.k0 = 128 * kb; c.n0 = n0;
        c.dst = (unsigned char*)(ws + WS_WGU) + (size_t)(l * NE + e) * 2 * FF * D; c.dst_row = (n0 / 128) * 256 + (n0 % 128) + (up ? 128 : 0); c.scale = pg8::WSC_UP; c.fp8 = true; return c; }
    r -= 2 * CV_G;
    { const int e = r / CV_DE, q = r % CV_DE, kb = q / (D / 32), nb = q % (D / 32);
        c.src = P.w_down + (size_t)(l * NE + e) * FF * D; c.ldw = D; c.K = FF; c.k0 = 128 * kb; c.n0 = 32 * nb;
        c.dst = (unsigned char*)(ws + WS_WD) + (size_t)(l * NE + e) * D * FF; c.dst_row = 32 * nb; c.scale = pg8::WSC_DOWN; c.fp8 = true; return c; }
}
DI void convert_range(Frame& F, const Ptrs& P, const int it_lo, const int it_hi, const int gw, const int NGW) {
    LAS float* scr = (LAS float*)(F.lds + F.wave * 16896);
    int it = it_lo + gw;
    if (it >= it_hi) return;
    f32x4 v[16];
    { const CvItem c0 = cv_decode(P, it); cv_load(c0, v, F.lane); }
#pragma unroll 1
    for (;;) {
        const int nx = it + NGW; const bool more = nx < it_hi;
        f32x4 w[16];
#pragma unroll
        for (int i = 0; i < 16; ++i) w[i] = v[i];
        if (more) { const CvItem cn = cv_decode(P, nx); cv_load(cn, v, F.lane); }
        { const CvItem cc = cv_decode(P, it); cv_store(cc, w, scr, F.lane); }
        if (!more) break;
        it = nx;
    }
}
DI void p0_prologue(Frame& F, const Ptrs& P, const bool do_mod) {
    unsigned char* ws = P.ws;
    convert_range(F, P, 0, CV_TOTAL - CV_DEFER, F.bid * NWAVES + F.wave, F.G * NWAVES);
    {
        bf16_t* w16 = (bf16_t*)(ws + WS_W16);
        for (int idx = F.bid * NTHR + F.tid; idx < DEPTH * 2 * 16 * D; idx += F.G * NTHR) {
            const int k = idx % D, n = (idx / D) % 16, m = (idx / (16 * D)) % 2, l = idx / (2 * 16 * D);
            const float v = m ? P.w_router[((size_t)l * D + k) * NE + n] : P.w_in[((size_t)l * D + k) * INW + C_MG + n];
            w16[idx] = (bf16_t)(pk2(v, 0.f) & 0xffffu);
        }
    }
    {
        float* rc = (float*)(ws + WS_ROPEC); float* rs = (float*)(ws + WS_ROPES);
        for (int idx = F.bid * NTHR + F.tid; idx < SEQ * 64; idx += F.G * NTHR) {
            const int pos = idx >> 6, j = idx & 63;
            const float pw = (float)exp(9.210340371976184 * ((double)j / 64.0));
            const float inv = 1.0f / pw;
            const float ang = (float)pos * inv;
            rc[idx] = (float)cos((double)ang); rs[idx] = (float)sin((double)ang);
        }
    }
    __syncthreads();
    if (do_mod) {
        LAS float* cact = (LAS float*)F.lds;
        LAS float* red = (LAS float*)(F.lds + 32768);
        for (int i = F.tid; i < NB * D; i += NTHR) { const float v = P.c[i]; cact[i] = v / (1.0f + expf(-v)); }
        __syncthreads();
        float* MOD = (float*)(ws + WS_MOD);
        for (int task = F.bid; task < DEPTH * 384; task += F.G) {
            const int l = task / 384, nc = task % 384, col = F.lane & 31, n = nc * 32 + col, k0 = F.wave * 256 + (F.lane >> 5) * 128;
            float acc[NB];
#pragma unroll
            for (int b = 0; b < NB; ++b) acc[b] = 0.f;
            const float* wp = P.w_ada + ((size_t)l * D + k0) * (6 * D) + n;
#pragma unroll 16
            for (int i = 0; i < 128; ++i) { const float wv = wp[(size_t)i * 6 * D];
#pragma unroll
                for (int b = 0; b < NB; ++b) acc[b] += wv * cact[b * D + k0 + i]; }
#pragma unroll
            for (int b = 0; b < NB; ++b) { acc[b] += shx(acc[b], 32, F.lane); if (F.lane < 32) red[(F.wave * NB + b) * 32 + col] = acc[b]; }
            __syncthreads();
            if (F.tid < NB * 32) { const int b = F.tid >> 5, nn = F.tid & 31; float s = 0.f;
#pragma unroll
                for (int w = 0; w < 8; ++w) s += red[(w * NB + b) * 32 + nn];
                MOD[((size_t)l * NB + b) * 6 * D + nc * 32 + nn] = s + P.b_ada[(size_t)l * 6 * D + nc * 32 + nn]; }
            __syncthreads();
        }
    }
}

template <int MODE, bool XBF>
DI void norm_phase(Frame& F, const void* xin_, const float* mod_sh, const float* mod_sc, const bf16_t* W16T, const float* bias16, bf16_t* Hout, unsigned char* H8out, float* out16) {
    constexpr int HROW = 4096 + 16;
    LAS unsigned char* HT = F.lds;
    LAS float* PP = (LAS float*)(F.lds + 16 * HROW);
    const int w = F.wave, lane = F.lane, l15 = lane & 15, kq = lane >> 4, tid = F.tid;
    bf16x8 bw[8];
#pragma unroll
    for (int i = 0; i < 8; ++i) bw[i] = *(const bf16x8*)(W16T + (size_t)l15 * D + 32 * (8 * w + i) + 8 * kq);
    typedef typename std::conditional<XBF, u32x2, f32x4>::type raw_t;
    raw_t vr[2][8];
#define NP_LOAD(blk_) do { _Pragma("unroll") for (int rr = 0; rr < 2; ++rr) { const size_t xo = (size_t)((blk_) * 16 + 2 * w + rr) * D + 4 * lane; \
        _Pragma("unroll") for (int j = 0; j < 8; ++j) { if constexpr (XBF) vr[rr][j] = *(const u32x2*)((const bf16_t*)xin_ + xo + 256 * j); else vr[rr][j] = *(const f32x4*)((const float*)xin_ + xo + 256 * j); } } } while (0)
    if (F.bid < MTOK / 16) NP_LOAD(F.bid);
    for (int blk = F.bid; blk < MTOK / 16; blk += F.G) {
        __syncthreads();
        f32x4 v[2][8];
#pragma unroll
        for (int rr = 0; rr < 2; ++rr)
#pragma unroll
            for (int j = 0; j < 8; ++j) {
                if constexpr (XBF) { const u32x2 t = vr[rr][j];
                    v[rr][j] = (f32x4){__uint_as_float(t.x << 16), __uint_as_float(t.x & 0xffff0000u), __uint_as_float(t.y << 16), __uint_as_float(t.y & 0xffff0000u)}; }
                else v[rr][j] = vr[rr][j]; }
        if (blk + F.G < MTOK / 16) NP_LOAD(blk + F.G);
#pragma unroll
        for (int rr = 0; rr < 2; ++rr) {
            const int row = blk * 16 + 2 * w + rr, b = row / SEQ;
            float ss = 0.f;
#pragma unroll
            for (int j = 0; j < 8; ++j) ss += (v[rr][j].x * v[rr][j].x + v[rr][j].y * v[rr][j].y) + (v[rr][j].z * v[rr][j].z + v[rr][j].w * v[rr][j].w);
            ss = wave_sum(ss, lane);
            const float rstd = 1.0f / sqrtf(ss * (1.0f / D) + EPS);
            const float* shp = mod_sh + (size_t)b * 6 * D + 4 * lane; const float* scp = mod_sc + (size_t)b * 6 * D + 4 * lane;
            bf16_t* hr = Hout + (size_t)row * D + 4 * lane;
            LAS unsigned char* hl = HT + (2 * w + rr) * HROW + 8 * lane;
#pragma unroll
            for (int j = 0; j < 8; ++j) { const f32x4 sh = *(const f32x4*)(shp + 256 * j), sc = *(const f32x4*)(scp + 256 * j);
                const f32x4 hv = v[rr][j] * rstd * (sc + 1.0f) + sh;
                u32x2 o; o.x = pk2(hv.x, hv.y); o.y = pk2(hv.z, hv.w); *(LAS u32x2*)(hl + 512 * j) = o;
                if (MODE == 0) *(u32x2*)(hr + 256 * j) = o;
                *(unsigned*)(H8out + (size_t)row * D + 4 * lane + 256 * j) = pg8::pk4_fp8(hv.x, hv.y, hv.z, hv.w); }
        }
        __syncthreads();
        f32x4 acc = (f32x4){0.f, 0.f, 0.f, 0.f};
#pragma unroll
        for (int i = 0; i < 8; ++i) { const int ks = 8 * w + i;
            const bf16x8 A = *(const LAS bf16x8*)(HT + l15 * HROW + (32 * ks + 8 * kq) * 2);
            acc = MFMA16(A, bw[i], acc); }
        *(LAS f32x4*)(PP + w * 256 + lane * 4) = acc;
        __syncthreads();
        if (tid < 256) {
            const int r = tid >> 4, n = tid & 15; float val = 0.f;
#pragma unroll
            for (int ww = 0; ww < 8; ++ww) val += PP[ww * 256 + ((r >> 2) * 16 + n) * 4 + (r & 3)];
            if (MODE == 0) val += bias16[n];
            else {
                float m = val;
#pragma unroll
                for (int o = 1; o < 16; o <<= 1) m = fmaxf(m, shx(m, o, lane));
                const float e = expf(val - m); float s = e;
#pragma unroll
                for (int o = 1; o < 16; o <<= 1) s += shx(s, o, lane);
                val = e / s;
            }
            out16[(size_t)(blk * 16 + r) * 16 + n] = val;
        }
    }
#undef NP_LOAD
}

DI unsigned offb(unsigned row, unsigned ch) { return 256u * row + 16u * (ch ^ (((row & 3u) << 2) | ((row >> 2) & 3u))); }
DI s16x4 trrd(const LAS unsigned char* img, unsigned rowbase, unsigned c, int lane) {
    const unsigned blk = (lane >> 4) & 1, q = (lane & 15) >> 2, p = lane & 3;
    return __builtin_amdgcn_ds_read_tr16_b64_v4i16((LAS s16x4*)(img + offb(rowbase + q, 4 * c + 2 * blk + (p >> 1)) + 8 * (p & 1)));
}
DI int crow(int reg, int hh) { return (reg & 3) + 8 * (reg >> 2) + 4 * hh; }
DI unsigned trbase(unsigned rowbase0, unsigned c, int lane) { const unsigned blk = (lane >> 4) & 1, q = (lane & 15) >> 2, p = lane & 3; return offb(rowbase0 + q, 4 * c + 2 * blk + (p >> 1)) + 8 * (p & 1); }
DI s16x4 trat(const LAS unsigned char* p) { return __builtin_amdgcn_ds_read_tr16_b64_v4i16((LAS s16x4*)p); }

DI void attn_unit(Frame& F, int unit, const bf16_t* PROJ, const float* ropec, const float* ropes, const float* qg, const float* kg, const float* sinkp, bf16_t* MIX) {
    LAS unsigned char* KI = F.lds;
    LAS unsigned char* VI = F.lds + 32768;
    const int pair = unit & 1, kvh = (unit >> 1) & 1, qblk = (unit >> 2) & 15, b = unit >> 6;
    const int w = F.wave, lane = F.lane, r = lane & 31, hh = lane >> 5;
    const int head = kvh * 4 + pair * 2 + (w >> 2);
    const int tq0 = qblk * 128 + (w & 3) * 32, tq = tq0 + r;
    constexpr float QS = 0.08838834764831845f * LOG2E;
    bf16x8 qf[8];
    {
        const bf16_t* qrow = PROJ + (size_t)(b * SEQ + tq) * INWG + C_AQ + head * 128 + 8 * hh;
        float x[8][8]; float ss = 0.f;
#pragma unroll
        for (int k = 0; k < 8; ++k) { unpack8(*(const u32x4*)(qrow + 16 * k), x[k]);
#pragma unroll
            for (int j = 0; j < 8; ++j) ss += x[k][j] * x[k][j]; }
        ss += shx(ss, 32, lane);
        const float rstd = __builtin_amdgcn_rsqf(ss * (1.0f / 128.0f) + EPS);
#pragma unroll
        for (int k = 0; k < 8; ++k) { asm volatile("" ::: "memory");
            const f32x4 g0 = *(const f32x4*)(qg + 16 * k + 8 * hh), g1 = *(const f32x4*)(qg + 16 * k + 8 * hh + 4);
#pragma unroll
            for (int j = 0; j < 4; ++j) { x[k][j] *= rstd * g0[j]; x[k][4 + j] *= rstd * g1[j]; } }
#pragma unroll
        for (int k = 0; k < 4; ++k) { asm volatile("" ::: "memory");
            const float* cp = ropec + (size_t)tq * 64 + 16 * k + 8 * hh; const float* sp = ropes + (size_t)tq * 64 + 16 * k + 8 * hh;
            const f32x4 c0 = *(const f32x4*)cp, c1 = *(const f32x4*)(cp + 4), s0 = *(const f32x4*)sp, s1 = *(const f32x4*)(sp + 4);
            float lo[8], hi[8];
#pragma unroll
            for (int j = 0; j < 8; ++j) { const float cc = j < 4 ? c0[j] : c1[j - 4], sn = j < 4 ? s0[j] : s1[j - 4];
                lo[j] = (x[k][j] * cc - x[k + 4][j] * sn) * QS; hi[j] = (x[k + 4][j] * cc + x[k][j] * sn) * QS; }
            qf[k] = __builtin_bit_cast(bf16x8, pack8(lo)); qf[k + 4] = __builtin_bit_cast(bf16x8, pack8(hi));
        }
        asm volatile("" ::: "memory");
    }
    unsigned kro[8], vb[4][2];
#pragma unroll
    for (int ks = 0; ks < 8; ++ks) kro[ks] = offb(r, 2 * ks + hh);
#pragma unroll
    for (int dvt = 0; dvt < 4; ++dvt) { vb[dvt][0] = trbase(4 * hh, dvt, lane); vb[dvt][1] = trbase(4 * hh + 8, dvt, lane); }
    float m_run = sinkp[head] * LOG2E, l_run = 1.0f;
    f32x16 oacc[4];
#pragma unroll
    for (int i = 0; i < 4; ++i)
#pragma unroll
        for (int j = 0; j < 16; ++j) oacc[i][j] = 0.f;
    for (int kbi = -1; kbi <= 1; ++kbi) {
        const int kb = qblk + kbi;
        if (kb < 0 || kb >= SEQ / 128) continue;
        __syncthreads();
        u32x4 kraw[4], vraw[4];
#pragma unroll
        for (int i = 0; i < 4; ++i) { const int task = F.tid + NTHR * i, s = task >> 4, c = task & 15;
            const bf16_t* prow = PROJ + (size_t)(b * SEQ + kb * 128 + s) * INWG;
            kraw[i] = *(const u32x4*)(prow + C_AK + kvh * 128 + 8 * c); vraw[i] = *(const u32x4*)(prow + C_AV + kvh * 128 + 8 * c); }
#pragma unroll
        for (int i = 0; i < 4; ++i) {
            asm volatile("" ::: "memory");
            const int task = F.tid + NTHR * i, s = task >> 4, c = task & 15, pos = kb * 128 + s;
            float x[8], pr[8], o[8]; unpack8(kraw[i], x);
            float ss = 0.f;
#pragma unroll
            for (int j = 0; j < 8; ++j) ss += x[j] * x[j];
            ss += shx(ss, 1, lane); ss += shx(ss, 2, lane); ss += shx(ss, 4, lane); ss += shx(ss, 8, lane);
            const float rstd = __builtin_amdgcn_rsqf(ss * (1.0f / 128.0f) + EPS);
            const f32x4 g0 = *(const f32x4*)(kg + 8 * c), g1 = *(const f32x4*)(kg + 8 * c + 4);
#pragma unroll
            for (int j = 0; j < 8; ++j) x[j] *= rstd * (j < 4 ? g0[j] : g1[j - 4]);
#pragma unroll
            for (int j = 0; j < 8; ++j) pr[j] = shx(x[j], 8, lane);
            const float* cp = ropec + (size_t)pos * 64 + 8 * (c & 7); const float* sp = ropes + (size_t)pos * 64 + 8 * (c & 7);
            const f32x4 c0 = *(const f32x4*)cp, c1 = *(const f32x4*)(cp + 4), s0 = *(const f32x4*)sp, s1 = *(const f32x4*)(sp + 4);
#pragma unroll
            for (int j = 0; j < 8; ++j) { const float cc = j < 4 ? c0[j] : c1[j - 4], sn = j < 4 ? s0[j] : s1[j - 4];
                o[j] = (c < 8) ? (x[j] * cc - pr[j] * sn) : (x[j] * cc + pr[j] * sn); }
            *(LAS u32x4*)(KI + offb(s, c)) = pack8(o);
            *(LAS u32x4*)(VI + offb(s, c)) = vraw[i];
        }
        __syncthreads();
#pragma unroll 1
        for (int sub = 0; sub < 2; ++sub) {
            const int kpos0 = kb * 128 + sub * 64;
            if (kpos0 > tq0 + 31 + 128 || kpos0 + 63 < tq0 - 128) continue;
            f32x16 st[2];
#pragma unroll
            for (int kt = 0; kt < 2; ++kt) { asm volatile("" ::: "memory");
#pragma unroll
                for (int j = 0; j < 16; ++j) st[kt][j] = 0.f;
#pragma unroll
                for (int ks = 0; ks < 8; ++ks) { const bf16x8 a = *(const LAS bf16x8*)(KI + 256 * (sub * 64 + kt * 32) + kro[ks]);
                    st[kt] = MFMA32(a, qf[ks], st[kt]); }
            }
            float mx = -INFINITY;
#pragma unroll
            for (int kt = 0; kt < 2; ++kt)
#pragma unroll
                for (int rg = 0; rg < 16; ++rg) { const int kp = kpos0 + kt * 32 + (rg & 3) + 8 * (rg >> 2) + 4 * hh, dl = kp - tq;
                    const float sv = (dl <= 128 && dl >= -128) ? st[kt][rg] : -INFINITY; st[kt][rg] = sv; mx = fmaxf(mx, sv); }
            mx = fmaxf(mx, shx(mx, 32, lane));
            const float m_new = fmaxf(m_run, mx), alpha = fast_exp2(m_run - m_new);
            float rs = 0.f;
#pragma unroll
            for (int kt = 0; kt < 2; ++kt)
#pragma unroll
                for (int rg = 0; rg < 16; ++rg) { const float p = fast_exp2(st[kt][rg] - m_new); st[kt][rg] = p; rs += p; }
            rs += shx(rs, 32, lane);
            l_run = l_run * alpha + rs; m_run = m_new;
#pragma unroll
            for (int i = 0; i < 4; ++i)
#pragma unroll
                for (int j = 0; j < 16; ++j) oacc[i][j] *= alpha;
            bf16x8 pf[2][2];
#pragma unroll
            for (int kt = 0; kt < 2; ++kt)
#pragma unroll
                for (int s2 = 0; s2 < 2; ++s2) { float t8[8];
#pragma unroll
                    for (int j = 0; j < 8; ++j) t8[j] = st[kt][8 * s2 + j];
                    pf[kt][s2] = __builtin_bit_cast(bf16x8, pack8(t8)); }
#pragma unroll
            for (int dvt = 0; dvt < 4; ++dvt) { asm volatile("" ::: "memory");
#pragma unroll
                for (int kt = 0; kt < 2; ++kt)
#pragma unroll
                    for (int s2 = 0; s2 < 2; ++s2) { const int sb = sub * 64 + kt * 32 + 16 * s2;
                        const s16x4 lo = trat(VI + 256 * sb + vb[dvt][0]), hi = trat(VI + 256 * sb + vb[dvt][1]);
                        const bf16x8 a = __builtin_shufflevector(lo, hi, 0, 1, 2, 3, 4, 5, 6, 7);
                        oacc[dvt] = MFMA32(a, pf[kt][s2], oacc[dvt]); } }
        }
    }
    const float inv = 1.0f / l_run;
    bf16_t* orow = MIX + (size_t)(b * SEQ + tq) * D + head * 128 + 8 * hh;
#pragma unroll
    for (int dvt = 0; dvt < 4; ++dvt)
#pragma unroll
        for (int ip = 0; ip < 2; ++ip) { u32x2 o[2];
#pragma unroll
            for (int q = 0; q < 2; ++q) { const int i = 2 * ip + q; o[q].x = pk2(oacc[dvt][4 * i] * inv, oacc[dvt][4 * i + 1] * inv); o[q].y = pk2(oacc[dvt][4 * i + 2] * inv, oacc[dvt][4 * i + 3] * inv); }
            *(u32x4*)(orow + dvt * 32 + 16 * ip) = widen_pair(o[0], o[1]); }
}

constexpr int ML_L = 256, ML_NC = SEQ / ML_L;
constexpr float ML_SC = 0.08838834764831845f;
DI size_t scal_idx(int dir, int kind, int b, int h) { return ((size_t)((dir * 3 + kind) * NB + b) * 4 + h) * SEQ; }

DI void mlA_unit(Frame& F, int unit, const bf16_t* PROJ, const float* GATES, bf16_t* NUMF, bf16_t* NUMB, float* SCAL, float* U, float* UN, float* AA) {
    LAS unsigned char* KI = F.lds;
    LAS unsigned char* VI = F.lds + 65536;
    LAS float* SA = (LAS float*)(F.lds + 131072);
    LAS float* CS = SA + 6 * 256;
    const int dvh = unit & 1, j = (unit >> 1) & 7, h = (unit >> 4) & 3, b = unit >> 6;
    const int w = F.wave, lane = F.lane, r = lane & 31, hh = lane >> 5, tid = F.tid;
    _Pragma("unroll 1") for (int rp0_ = 0; rp0_ < REP_MLS; ++rp0_) {
    __syncthreads();
    {
        u32x4 kr[8], vr[8];
#pragma unroll
        for (int i = 0; i < 8; ++i) { const int task = tid + NTHR * i, s = task >> 4, ch = task & 15;
            const bf16_t* prow = PROJ + (size_t)(b * SEQ + j * ML_L + s) * INWG;
            kr[i] = *(const u32x4*)(prow + C_MK + h * 128 + 8 * ch); vr[i] = *(const u32x4*)(prow + C_MV + h * 256 + dvh * 128 + 8 * ch); }
        float ka[2][4], kb[2][4], kam[2][4];
#pragma unroll
        for (int dir = 0; dir < 2; ++dir) {
            float ig[4], lf[4];
#pragma unroll
            for (int e = 0; e < 4; ++e) { const int p = w * ML_L + 4 * lane + e, tok = dir ? (SEQ - 1 - p) : p; const float* gp = GATES + (size_t)(b * SEQ + tok) * 16;
                ig[e] = gp[dir * 4 + h]; const float fg = gp[(2 + dir) * 4 + h]; lf[e] = fminf(fg, 0.f) - log1pf(expf(-fabsf(fg))); }
            float bc[4]; bc[0] = lf[0]; bc[1] = bc[0] + lf[1]; bc[2] = bc[1] + lf[2]; bc[3] = bc[2] + lf[3];
            float incl = bc[3];
#pragma unroll
            for (int o = 1; o < 64; o <<= 1) { const float t = shup(incl, o, lane); if (lane >= o) incl += t; }
            const float excl = incl - bc[3], btot = rdlane(incl, 63);
            float am[4];
#pragma unroll
            for (int e = 0; e < 4; ++e) { kb[dir][e] = excl + bc[e]; ka[dir][e] = ig[e] - kb[dir][e]; am[e] = e ? fmaxf(am[e - 1], ka[dir][e]) : ka[dir][0]; }
            float inclm = am[3];
#pragma unroll
            for (int o = 1; o < 64; o <<= 1) { const float t = shup(inclm, o, lane); if (lane >= o) inclm = fmaxf(inclm, t); }
            float exclm = shup(inclm, 1, lane); if (lane == 0) exclm = -INFINITY;
#pragma unroll
            for (int e = 0; e < 4; ++e) kam[dir][e] = fmaxf(exclm, am[e]);
            if (lane == 0) { CS[(dir * 8 + w) * 2] = btot; CS[(dir * 8 + w) * 2 + 1] = btot + rdlane(inclm, 63); }
        }
#pragma unroll
        for (int i = 0; i < 8; ++i) { const int task = tid + NTHR * i, s = task >> 4, ch = task & 15;
            *(LAS u32x4*)(KI + offb(s, ch)) = kr[i]; *(LAS u32x4*)(VI + offb(s, ch)) = vr[i]; }
        __syncthreads();
#pragma unroll
        for (int dir = 0; dir < 2; ++dir) {
            const int c = dir ? (ML_NC - 1 - j) : j;
            if (w == c) {
                float m_prev = 0.f;
                for (int cc = 0; cc < c; ++cc) m_prev = fmaxf(CS[(dir * 8 + cc) * 2] + m_prev, CS[(dir * 8 + cc) * 2 + 1]);
                const float btot = CS[(dir * 8 + c) * 2], m_new = fmaxf(btot + m_prev, CS[(dir * 8 + c) * 2 + 1]);
                if (lane == 0) AA[((dir * NB + b) * 4 + h) * ML_NC + c] = expf(btot + m_prev - m_new);
#pragma unroll
                for (int e = 0; e < 4; ++e) { const int pl = 4 * lane + e, toff = dir ? (ML_L - 1 - pl) : pl;
                    const float mm = fmaxf(kam[dir][e], m_prev);
                    SA[(dir * 3 + 0) * 256 + toff] = ka[dir][e] * LOG2E - 3.5f; SA[(dir * 3 + 1) * 256 + toff] = mm * LOG2E;     SA[(dir * 3 + 2) * 256 + toff] = expf(btot + ka[dir][e] - m_new);
                    if (dvh == 0) { const int tok = j * ML_L + toff;
                        SCAL[scal_idx(dir, 1, b, h) + tok] = expf(m_prev - mm) * ML_SC; SCAL[scal_idx(dir, 2, b, h) + tok] = expf(-(kb[dir][e] + mm)); } }
            }
        }
        __syncthreads();
    }
    }
    _Pragma("unroll 1") for (int rp1_ = 0; rp1_ < REP_ML1; ++rp1_) {
        const int tok = j * ML_L + 32 * w + r;
        bf16x8 qf[8];
        { const bf16_t* qrow = PROJ + (size_t)(b * SEQ + tok) * INWG + C_MQ + h * 128 + 8 * hh;
#pragma unroll
            for (int ks = 0; ks < 8; ++ks) qf[ks] = *(const bf16x8*)(qrow + 16 * ks); }
        unsigned kb[8], vb[4][2];
#pragma unroll
        for (int ks = 0; ks < 8; ++ks) kb[ks] = offb(r, 2 * ks + hh);
#pragma unroll
        for (int dvt = 0; dvt < 4; ++dvt) { vb[dvt][0] = trbase(4 * hh, dvt, lane); vb[dvt][1] = trbase(4 * hh + 8, dvt, lane); }
#pragma unroll 1
        for (int dir = 0; dir < 2; ++dir) {
            const LAS float* a_s = SA + (dir * 3 + 0) * 256; const float mm_t = SA[(dir * 3 + 1) * 256 + 32 * w + r];
            f32x16 oacc[4];
#pragma unroll
            for (int i = 0; i < 4; ++i)
#pragma unroll
                for (int q = 0; q < 16; ++q) oacc[i][q] = 0.f;
            float den = 0.f;
            const int k_lo = dir ? w : 0, k_hi = dir ? 7 : w;
#pragma unroll 1
            for (int kti = k_lo; kti <= k_hi; ++kti) {
                const int s0 = 32 * kti;
                const LAS unsigned char* kt = KI + 256 * s0; const LAS unsigned char* vt = VI + 256 * s0;
                f32x16 st;
#pragma unroll
                for (int q = 0; q < 16; ++q) st[q] = 0.f;
#pragma unroll
                for (int ks = 0; ks < 8; ++ks) { const bf16x8 a = *(const LAS bf16x8*)(kt + kb[ks]); st = MFMA32(a, qf[ks], st); }
                const bool diag = (kti == w);
#pragma unroll
                for (int g = 0; g < 4; ++g) { const f32x4 av = *(const LAS f32x4*)(a_s + s0 + 8 * g + 4 * hh);
#pragma unroll
                    for (int e = 0; e < 4; ++e) { const int sl = 8 * g + 4 * hh + e;
                        const bool ok = !diag || (dir ? (sl >= r) : (sl <= r));
                        const float p = ok ? st[4 * g + e] * fast_exp2(av[e] - mm_t) : 0.f; st[4 * g + e] = p; den += p; } }
                bf16x8 pf[2];
#pragma unroll
                for (int s2 = 0; s2 < 2; ++s2) { float t8[8];
#pragma unroll
                    for (int q = 0; q < 8; ++q) t8[q] = st[8 * s2 + q];
                    pf[s2] = __builtin_bit_cast(bf16x8, pack8(t8)); }
#pragma unroll
                for (int dvt = 0; dvt < 4; ++dvt)
#pragma unroll
                    for (int s2 = 0; s2 < 2; ++s2) { const s16x4 lo = trat(vt + vb[dvt][0] + 4096 * s2), hi = trat(vt + vb[dvt][1] + 4096 * s2);
                        const bf16x8 a = __builtin_shufflevector(lo, hi, 0, 1, 2, 3, 4, 5, 6, 7);
                        oacc[dvt] = MFMA32(a, pf[s2], oacc[dvt]); }
            }
            den += shx(den, 32, lane);
            bf16_t* NUM = dir ? NUMB : NUMF;
            bf16_t* orow = NUM + (size_t)(b * SEQ + tok) * 1024 + h * 256 + dvh * 128 + 8 * hh;
#pragma unroll
            for (int dvt = 0; dvt < 4; ++dvt)
#pragma unroll
                for (int gp = 0; gp < 2; ++gp) { u32x2 o[2];
#pragma unroll
                    for (int q = 0; q < 2; ++q) { const int g = 2 * gp + q; o[q].x = pk2(oacc[dvt][4 * g], oacc[dvt][4 * g + 1]); o[q].y = pk2(oacc[dvt][4 * g + 2], oacc[dvt][4 * g + 3]); }
                    *(u32x4*)(orow + dvt * 32 + 16 * gp) = widen_pair(o[0], o[1]); }
            if (dvh == 0 && hh == 0) SCAL[scal_idx(dir, 0, b, h) + tok] = den;
        }
    }
    _Pragma("unroll 1") for (int rp2_ = 0; rp2_ < REP_ML2; ++rp2_) {
        const int dvt = w & 3, dkt0 = 2 * (w >> 2);
        f32x16 ua[2][2];
#pragma unroll
        for (int d = 0; d < 2; ++d)
#pragma unroll
            for (int i = 0; i < 2; ++i)
#pragma unroll
                for (int q = 0; q < 16; ++q) ua[d][i][q] = 0.f;
        const unsigned vb0 = trbase(8 * hh, dvt, lane), vb1 = trbase(8 * hh + 4, dvt, lane);
        unsigned kb0[2], kb1[2];
#pragma unroll
        for (int i = 0; i < 2; ++i) { kb0[i] = trbase(8 * hh, dkt0 + i, lane); kb1[i] = trbase(8 * hh + 4, dkt0 + i, lane); }
#pragma unroll 2
        for (int ks = 0; ks < 16; ++ks) {
            const int s0 = 16 * ks;
            const s16x4 vlo = trat(VI + vb0 + 4096 * ks), vhi = trat(VI + vb1 + 4096 * ks);
            float v8[8]; unpack8(__builtin_bit_cast(u32x4, __builtin_shufflevector(vlo, vhi, 0, 1, 2, 3, 4, 5, 6, 7)), v8);
            bf16x8 bw[2];
#pragma unroll
            for (int d = 0; d < 2; ++d) { const f32x4 wa = *(const LAS f32x4*)(SA + (d * 3 + 2) * 256 + s0 + 8 * hh), wb = *(const LAS f32x4*)(SA + (d * 3 + 2) * 256 + s0 + 8 * hh + 4);
                float x8[8];
#pragma unroll
                for (int q = 0; q < 4; ++q) { x8[q] = v8[q] * wa[q]; x8[4 + q] = v8[4 + q] * wb[q]; }
                bw[d] = __builtin_bit_cast(bf16x8, pack8(x8)); }
#pragma unroll
            for (int i = 0; i < 2; ++i) { const s16x4 klo = trat(KI + kb0[i] + 4096 * ks), khi = trat(KI + kb1[i] + 4096 * ks);
                const bf16x8 a = __builtin_shufflevector(klo, khi, 0, 1, 2, 3, 4, 5, 6, 7);
                ua[0][i] = MFMA32(bw[0], a, ua[0][i]); ua[1][i] = MFMA32(bw[1], a, ua[1][i]); }
        }
#pragma unroll
        for (int d = 0; d < 2; ++d) { const int c = d ? (ML_NC - 1 - j) : j;
            float* up = U + ((size_t)(((d * NB + b) * 4 + h) * ML_NC + c) * 128) * 256 + dvh * 128 + dvt * 32 + 4 * hh;
#pragma unroll
            for (int i = 0; i < 2; ++i)
#pragma unroll
                for (int g = 0; g < 4; ++g) *(f32x4*)(up + (size_t)(32 * (dkt0 + i) + r) * 256 + 8 * g) = (f32x4){ua[d][i][4 * g], ua[d][i][4 * g + 1], ua[d][i][4 * g + 2], ua[d][i][4 * g + 3]}; }
        if (dvh == 0) {
            const int dkt = w & 3, d = w >> 2, c = d ? (ML_NC - 1 - j) : j;
            const unsigned k0 = trbase(8 * hh, dkt, lane), k1 = trbase(8 * hh + 4, dkt, lane);
            f32x16 un;
#pragma unroll
            for (int q = 0; q < 16; ++q) un[q] = 0.f;
#pragma unroll 4
            for (int ks = 0; ks < 16; ++ks) {
                const f32x4 wa = *(const LAS f32x4*)(SA + (d * 3 + 2) * 256 + 16 * ks + 8 * hh), wb = *(const LAS f32x4*)(SA + (d * 3 + 2) * 256 + 16 * ks + 8 * hh + 4);
                u32x4 bwv; bwv.x = pk2(wa[0], wa[1]); bwv.y = pk2(wa[2], wa[3]); bwv.z = pk2(wb[0], wb[1]); bwv.w = pk2(wb[2], wb[3]);
                const s16x4 klo = trat(KI + k0 + 4096 * ks), khi = trat(KI + k1 + 4096 * ks);
                const bf16x8 a = __builtin_shufflevector(klo, khi, 0, 1, 2, 3, 4, 5, 6, 7);
                un = MFMA32(__builtin_bit_cast(bf16x8, bwv), a, un); }
            if (hh == 0) UN[((size_t)((d * NB + b) * 4 + h) * ML_NC + c) * 128 + 32 * dkt + r] = un[0];
        }
    }
}

DI void mlB_phase(Frame& F, const float* U, const float* UN, const float* AA, bf16_t* CPREV, float* NPREV) {
    const int gt = F.bid * NTHR + F.tid, NT = F.G * NTHR;
    for (int item = gt; item < 32 * 8192; item += NT) {
        const int sq = item >> 13, e4 = item & 8191;
        f32x4 C = (f32x4){0.f, 0.f, 0.f, 0.f};
        f32x4 u[ML_NC - 1];
#pragma unroll
        for (int c = 0; c < ML_NC - 1; ++c) u[c] = *(const f32x4*)(U + ((size_t)(sq * ML_NC + c) * 8192 + e4) * 4);
#pragma unroll
        for (int c = 0; c < ML_NC - 1; ++c) { C = C * AA[sq * ML_NC + c] + u[c];
            u32x2 o; o.x = pk2(C.x, C.y); o.y = pk2(C.z, C.w); *(u32x2*)(CPREV + ((size_t)(sq * (ML_NC - 1) + c) * 8192 + e4) * 4) = o; }
    }
    for (int item = gt; item < 32 * 128; item += NT) {
        const int sq = item >> 7, dk = item & 127; float n = 0.f;
#pragma unroll
        for (int c = 0; c < ML_NC - 1; ++c) { n = n * AA[sq * ML_NC + c] + UN[(size_t)(sq * ML_NC + c) * 128 + dk]; NPREV[(size_t)(sq * (ML_NC - 1) + c) * 128 + dk] = n; }
    }
}

DI void mlC_unit(Frame& F, int unit, const bf16_t* PROJ, const bf16_t* NUMF, const bf16_t* NUMB, const float* SCAL, const bf16_t* CPREV, const float* NPREV, const float* m_gain, bf16_t* MIX) {
    LAS unsigned char* CI = F.lds;
    LAS float* NP = (LAS float*)(F.lds + 131072);
    LAS float* EX = NP + 256;
    const int th = unit & 1, j = (unit >> 1) & 7, h = (unit >> 4) & 3, b = unit >> 6;
    const int w = F.wave, lane = F.lane, r = lane & 31, hh = lane >> 5, tid = F.tid, tt = w >> 1, dh = w & 1;
    unsigned zz_ = 0u; asm volatile("" : "+v"(zz_));
    const int tok = j * ML_L + th * 128 + tt * 32 + r;
    bf16x8 qf[8];
    { const bf16_t* qrow = PROJ + (size_t)(b * SEQ + tok) * INWG + C_MQ + h * 128 + 8 * hh;
#pragma unroll
        for (int ks = 0; ks < 8; ++ks) qf[ks] = *(const bf16x8*)(qrow + 16 * ks); }
    float sc_den[2], sc_ei[2], sc_emt[2];
#pragma unroll
    for (int d = 0; d < 2; ++d) { sc_den[d] = SCAL[scal_idx(d, 0, b, h) + tok]; sc_ei[d] = SCAL[scal_idx(d, 1, b, h) + tok]; sc_emt[d] = SCAL[scal_idx(d, 2, b, h) + tok]; }
    __syncthreads();
#pragma unroll
    for (int d = 0; d < 2; ++d) { const int c = d ? (ML_NC - 1 - j) : j; const int sq = (d * NB + b) * 4 + h;
        const bf16_t* src = CPREV + (size_t)(sq * (ML_NC - 1) + (c > 0 ? c - 1 : 0)) * 32768;
#pragma unroll
        for (int i = 0; i < 8; ++i) { const int task = tid + NTHR * i, dk = task >> 5, ch = task & 31;
            u32x4 v = (u32x4){zz_, zz_, zz_, zz_}; if (c > 0) v = *(const u32x4*)(src + (size_t)dk * 256 + 8 * ch);
            *(LAS u32x4*)(CI + (d * 2 + (ch >> 4)) * 32768 + offb(dk, ch & 15)) = v; }
        if (tid < 128) NP[d * 128 + tid] = c > 0 ? NPREV[(size_t)(sq * (ML_NC - 1) + (c - 1)) * 128 + tid] : 0.f; }
    __syncthreads();
    unsigned cb[4][2];
#pragma unroll
    for (int dvt = 0; dvt < 4; ++dvt) { cb[dvt][0] = trbase(8 * hh, dvt, lane); cb[dvt][1] = trbase(8 * hh + 4, dvt, lane); }
    float eiv[2], inv[2];
#pragma unroll
    for (int d = 0; d < 2; ++d) {
        const int c = d ? (ML_NC - 1 - j) : j;
        float qn = 0.f;
#pragma unroll
        for (int ks = 0; ks < 8; ++ks) { float q8[8]; unpack8(__builtin_bit_cast(u32x4, qf[ks]), q8);
            const f32x4 na = *(const LAS f32x4*)(NP + d * 128 + 16 * ks + 8 * hh), nb = *(const LAS f32x4*)(NP + d * 128 + 16 * ks + 8 * hh + 4);
            qn += (q8[0] * na[0] + q8[1] * na[1]) + (q8[2] * na[2] + q8[3] * na[3]) + (q8[4] * nb[0] + q8[5] * nb[1]) + (q8[6] * nb[2] + q8[7] * nb[3]); }
        qn += shx(qn, 32, lane);
        const float deni = sc_den[d], ei = sc_ei[d], emt = sc_emt[d];
        eiv[d] = ei; inv[d] = 1.0f / fmaxf(fabsf(deni + ei * qn), emt);
    }
    float hs[4][16];
#pragma unroll
    for (int dvt = 0; dvt < 4; ++dvt) {
#pragma unroll
        for (int d = 0; d < 2; ++d) { asm volatile("" ::: "memory");
            const bf16_t* nrow = (d ? NUMB : NUMF) + (size_t)(b * SEQ + tok) * 1024 + h * 256 + dh * 128 + 8 * hh;
            const LAS unsigned char* img = CI + (d * 2 + dh) * 32768;
            f32x16 acc;
#pragma unroll
            for (int q = 0; q < 16; ++q) acc[q] = 0.f;
#pragma unroll
            for (int ks = 0; ks < 8; ++ks) { const s16x4 lo = trat(img + cb[dvt][0] + 4096 * ks), hi = trat(img + cb[dvt][1] + 4096 * ks);
                const bf16x8 a = __builtin_shufflevector(lo, hi, 0, 1, 2, 3, 4, 5, 6, 7);
                acc = MFMA32(a, qf[ks], acc); }
#pragma unroll
            for (int gp = 0; gp < 2; ++gp) { u32x2 nr2[2]; narrow_pair(*(const u32x4*)(nrow + dvt * 32 + 16 * gp), nr2[0], nr2[1]);
#pragma unroll
                for (int q = 0; q < 2; ++q) { const int g = 2 * gp + q; const u32x2 nr = nr2[q];
                    const float nv[4] = {__uint_as_float(nr.x << 16), __uint_as_float(nr.x & 0xffff0000u), __uint_as_float(nr.y << 16), __uint_as_float(nr.y & 0xffff0000u)};
#pragma unroll
                    for (int e = 0; e < 4; ++e) { const float v = (nv[e] + eiv[d] * acc[4 * g + e]) * inv[d]; hs[dvt][4 * g + e] = d ? hs[dvt][4 * g + e] + v : v; } } } }
    }
    float ss = 0.f;
#pragma unroll
    for (int i = 0; i < 4; ++i)
#pragma unroll
        for (int q = 0; q < 16; ++q) ss += hs[i][q] * hs[i][q];
    ss += shx(ss, 32, lane);
    if (hh == 0) EX[w * 32 + r] = ss;
    __syncthreads();
    ss += EX[(w ^ 1) * 32 + r];
    const float rstd = 1.0f / sqrtf(ss * (1.0f / 256.0f) + EPS);
    const int colb = h * 256 + dh * 128 + 4 * hh, colw = h * 256 + dh * 128 + 8 * hh;
    const bf16_t* morow = PROJ + (size_t)(b * SEQ + tok) * INWG + C_MO + colw;
    bf16_t* orow = MIX + (size_t)(b * SEQ + tok) * D + 1024 + colw;
#pragma unroll
    for (int dvt = 0; dvt < 4; ++dvt) { asm volatile("" ::: "memory");
#pragma unroll
        for (int gp = 0; gp < 2; ++gp) { u32x2 mo2[2], o2[2]; narrow_pair(*(const u32x4*)(morow + dvt * 32 + 16 * gp), mo2[0], mo2[1]);
#pragma unroll
            for (int q = 0; q < 2; ++q) { const int g = 2 * gp + q; const f32x4 mg = *(const f32x4*)(m_gain + colb + dvt * 32 + 8 * g); const u32x2 mo = mo2[q];
                const float m0 = __uint_as_float(mo.x << 16), m1 = __uint_as_float(mo.x & 0xffff0000u), m2 = __uint_as_float(mo.y << 16), m3 = __uint_as_float(mo.y & 0xffff0000u);
                const float r0 = hs[dvt][4 * g] * rstd * mg.x * fast_rcp(1.0f + fast_exp2(-m0 * LOG2E)), r1 = hs[dvt][4 * g + 1] * rstd * mg.y * fast_rcp(1.0f + fast_exp2(-m1 * LOG2E));
                const float r2 = hs[dvt][4 * g + 2] * rstd * mg.z * fast_rcp(1.0f + fast_exp2(-m2 * LOG2E)), r3 = hs[dvt][4 * g + 3] * rstd * mg.w * fast_rcp(1.0f + fast_exp2(-m3 * LOG2E));
                o2[q].x = pk2(r0, r1); o2[q].y = pk2(r2, r3); }
            *(u32x4*)(orow + dvt * 32 + 16 * gp) = widen_pair(o2[0], o2[1]); } }
}

DI void select_pair(Frame& F, const int nsel, const int (&bb)[2], const int (&ee)[2], const bool (&publish)[2], const float* AFF, LAS int* tbl, LAS unsigned* scr, float* GATEV, int* SLOT) {
    const int tid = F.tid, lane = F.lane, w = F.wave;
    unsigned key[2][4];
#pragma unroll
    for (int s = 0; s < 2; ++s)
#pragma unroll
        for (int i = 0; i < 4; ++i) key[s][i] = (s < nsel) ? __float_as_uint(AFF[(size_t)(bb[s] * SEQ + 4 * tid + i) * 16 + ee[s]]) : 0u;
    unsigned lo[2] = {0u, 0u};
    __syncthreads();
#pragma unroll 1
    for (int step = 0; step < 16; ++step) {
        const int sh = step < 15 ? 29 - 2 * step : 0; const int ncand = step < 15 ? 3 : 1;
        LAS unsigned* buf = scr + (step & 1) * 48;
#pragma unroll
        for (int s = 0; s < 2; ++s)
#pragma unroll
            for (int c = 0; c < 3; ++c) { const unsigned cand = lo[s] | ((unsigned)(c + 1) << sh);
                int cnt = 0;
#pragma unroll
                for (int i = 0; i < 4; ++i) cnt += __builtin_popcountll(__builtin_amdgcn_ballot_w64(key[s][i] >= cand));
                if (lane == 0) buf[(s * 3 + c) * 8 + w] = (unsigned)cnt; }
        __syncthreads();
#pragma unroll
        for (int s = 0; s < 2; ++s) { unsigned pick = 0u;
#pragma unroll
            for (int c = 0; c < 3; ++c) { unsigned tot = 0u;
#pragma unroll
                for (int ww = 0; ww < 8; ++ww) tot += buf[(s * 3 + c) * 8 + ww];
                if (c < ncand && tot >= (unsigned)CAP) pick = (unsigned)(c + 1); }
            lo[s] |= pick << sh; }
    }
    unsigned pc[2];
#pragma unroll
    for (int s = 0; s < 2; ++s) { unsigned ng = 0u, nq = 0u;
#pragma unroll
        for (int i = 0; i < 4; ++i) { ng += key[s][i] > lo[s]; nq += key[s][i] == lo[s]; }
        pc[s] = ng | (nq << 16); }
    unsigned incl[2] = {pc[0], pc[1]};
#pragma unroll
    for (int o = 1; o < 64; o <<= 1)
#pragma unroll
        for (int s = 0; s < 2; ++s) { const unsigned t = (unsigned)__builtin_amdgcn_ds_bpermute((lane >= o ? lane - o : lane) << 2, (int)incl[s]); if (lane >= o) incl[s] += t; }
    LAS unsigned* wt = scr + 96;
    if (lane == 63) { wt[w] = incl[0]; wt[8 + w] = incl[1]; }
    __syncthreads();
#pragma unroll
    for (int s = 0; s < 2; ++s) if (s < nsel) {
        unsigned before = incl[s] - pc[s], total = 0u;
#pragma unroll
        for (int ww = 0; ww < 8; ++ww) { const unsigned t = wt[s * 8 + ww]; total += t; if (ww < w) before += t; }
        const unsigned need = (unsigned)CAP - (total & 0xffffu);
        unsigned bg = before & 0xffffu, bq = before >> 16;
        const int be = bb[s] * NE + ee[s];
#pragma unroll
        for (int i = 0; i < 4; ++i) { const bool gt = key[s][i] > lo[s], eq = key[s][i] == lo[s];
            const bool selv = gt || (eq && bq < need);
            const int slot = (int)(bg + (bq < need ? bq : need));
            const int row = bb[s] * SEQ + 4 * tid + i;
            if (selv) { tbl[s * 256 + slot] = row; if (publish[s]) GATEV[be * CAP + slot] = __uint_as_float(key[s][i]); }
            if (publish[s]) SLOT[(size_t)row * 16 + ee[s]] = selv ? slot : -1;
            bg += gt; bq += eq; }
    }
    __syncthreads();
}

DI void unpack8_fp8(const u32x2 raw, float (&x)[8]) {
    const f32x2 a = __builtin_amdgcn_cvt_pk_f32_fp8((int)raw.x, false), b = __builtin_amdgcn_cvt_pk_f32_fp8((int)raw.x, true), c = __builtin_amdgcn_cvt_pk_f32_fp8((int)raw.y, false), d = __builtin_amdgcn_cvt_pk_f32_fp8((int)raw.y, true);
    x[0] = a[0]; x[1] = a[1]; x[2] = b[0]; x[3] = b[1]; x[4] = c[0]; x[5] = c[1]; x[6] = d[0]; x[7] = d[1];
}
template <bool OBF>
DI void combine_phase(Frame& F, const bf16_t* X1, const float* g2, const int* SLOT, const unsigned char* YE, void* OUT) {
    const int gw = F.bid * NWAVES + F.wave, NGW = F.G * NWAVES, lane = F.lane;
    for (int row = gw; row < MTOK; row += NGW) {
        const int b = row / SEQ;
        const int sl = SLOT[(size_t)row * 16 + (lane & 15)];
        float acc[4][8];
#pragma unroll
        for (int j = 0; j < 4; ++j)
#pragma unroll
            for (int i = 0; i < 8; ++i) acc[j][i] = 0.f;
        for (int e = 0; e < NE; ++e) { const int s = __builtin_amdgcn_readlane(sl, e);
            if (s >= 0) { const unsigned char* yr = YE + ((size_t)(b * NE + e) * CAP + s) * D + 8 * lane;
#pragma unroll
                for (int j = 0; j < 4; ++j) { float x8[8]; unpack8_fp8(*(const u32x2*)(yr + 512 * j), x8);
#pragma unroll
                    for (int i = 0; i < 8; ++i) acc[j][i] += x8[i]; } } }
#pragma unroll
        for (int j = 0; j < 4; ++j) { const int col = 512 * j + 8 * lane;
            float x8[8]; unpack8(*(const u32x4*)(X1 + (size_t)row * D + col), x8);
            const f32x4 ga = *(const f32x4*)(g2 + (size_t)b * 6 * D + col) * (1.0f / pg8::YSC), gb = *(const f32x4*)(g2 + (size_t)b * 6 * D + col + 4) * (1.0f / pg8::YSC);
#pragma unroll
            for (int i = 0; i < 4; ++i) { x8[i] += ga[i] * acc[j][i]; x8[4 + i] += gb[i] * acc[j][4 + i]; }
            if (OBF) *(u32x4*)((bf16_t*)OUT + (size_t)row * D + col) = pack8(x8);
            else { *(f32x4*)((float*)OUT + (size_t)row * D + col) = (f32x4){x8[0], x8[1], x8[2], x8[3]}; *(f32x4*)((float*)OUT + (size_t)row * D + col + 4) = (f32x4){x8[4], x8[5], x8[6], x8[7]}; } }
    }
}

struct Args { const float* in[15]; float* out; unsigned char* ws; int ph_lo, ph_hi; };
constexpr int PPL = 10;
constexpr int N_PHASES = 1 + PPL * DEPTH;
typedef const __attribute__((address_space(4))) Args* KArgs;
#ifndef PH_MASK
#define PH_MASK 0x7FF
#endif
#define PHASE_ENV() KArgs ap = (KArgs)__builtin_amdgcn_kernarg_segment_ptr(); asm volatile("" : "+s"(ap)); unsigned char* const ws = ap->ws; (void)ws; \
    Frame F = F0; { int t_ = F0.tid, b_ = F0.bid, g_ = F0.G; asm volatile("" : "+v"(t_), "+s"(b_), "+s"(g_)); F.tid = t_; F.lane = t_ & 63; F.wave = __builtin_amdgcn_readfirstlane(t_ >> 6); F.bid = b_; F.G = g_; }

__global__ void __launch_bounds__(NTHR, 2) hymba_fwd(Args args) {
    extern __shared__ __attribute__((aligned(16))) unsigned char lds_raw[];
    Frame F0; F0.lds = (LAS unsigned char*)lds_raw; F0.tid = threadIdx.x; F0.lane = F0.tid & 63; F0.wave = __builtin_amdgcn_readfirstlane(F0.tid >> 6); F0.G = gridDim.x; F0.bid = blockIdx.x;
    const int lo = args.ph_lo, hi = args.ph_hi;
    volatile LAS unsigned* misc = (volatile LAS unsigned*)(F0.lds + LDS_MISC);
    if (F0.tid < 4) misc[F0.tid] = 0u;
    __syncthreads();
    XcdBarrier bar; bar.bar = (unsigned*)(args.ws + WS_CTL); bar.x = 0; bar.st = misc;
    if (hi - lo > 1) bar = xcd_barrier_post((unsigned*)(args.ws + WS_CTL), misc);
#define PHK(k) ((k) == 0 ? 0 : (((k) - 1) % PPL) + 1)
#define IN(k) (((PH_MASK >> PHK(k)) & 1) && lo <= (k) && (k) < hi)
#define SEAM(k) do { if ((k) + 1 < hi) xcd_barrier(bar); } while (0)
#ifndef REP_MASK
#define REP_MASK 0
#endif

#define REPLOOP(k) _Pragma("unroll 1") for (int rep_ = 0, nrep_ = (((REP_MASK >> PHK(k)) & 1) ? 2 : 1); rep_ < nrep_; ++rep_, __syncthreads())

    if (IN(0)) {
        PHASE_ENV();
        Ptrs P; P.x = ap->in[0]; P.c = ap->in[1]; P.w_ada = ap->in[2]; P.b_ada = ap->in[3]; P.w_in = ap->in[4]; P.b_gates = ap->in[5]; P.q_gain = ap->in[6]; P.k_gain = ap->in[7];
        P.sink = ap->in[8]; P.m_gain = ap->in[9]; P.w_out = ap->in[10]; P.w_router = ap->in[11]; P.w_gate = ap->in[12]; P.w_up = ap->in[13]; P.w_down = ap->in[14]; P.out = ap->out; P.ws = ws;
        REPLOOP(0) p0_prologue(F, P, rep_ == 0); SEAM(0);
    }

#pragma unroll 1
    for (int l = 0; l < DEPTH; ++l) {
        const int pb = 1 + PPL * l;
        if (IN(pb + 0)) REPLOOP(pb + 0) { PHASE_ENV();
            const float* MOD = (const float*)(ws + WS_MOD) + (size_t)l * NB * 6 * D;
            const bf16_t* w16 = (const bf16_t*)(ws + WS_W16) + (size_t)(l * 2 + 0) * 16 * D;
            if (l == 0) norm_phase<0, false>(F, ap->in[0], MOD + 0 * D, MOD + 1 * D, w16, ap->in[5] + l * 16, (bf16_t*)(ws + WS_H), (unsigned char*)(ws + WS_H8), (float*)(ws + WS_GATES));
            else norm_phase<0, true>(F, ws + WS_X2, MOD + 0 * D, MOD + 1 * D, w16, ap->in[5] + l * 16, (bf16_t*)(ws + WS_H), (unsigned char*)(ws + WS_H8), (float*)(ws + WS_GATES));
        } if (IN(pb + 0)) SEAM(pb + 0);
        if (IN(pb + 1)) REPLOOP(pb + 1) { PHASE_ENV();
            pg8::SchedPlain<2 * D> S{(const bf16_t*)(ws + WS_H), (const bf16_t*)(ws + WS_WIN) + (size_t)l * INWG * D, MTOK / 256, INWA / 256, F.G, F.bid}; pg8::EpiStoreBf16 E{(bf16_t*)(ws + WS_PROJ), INWG, 1.0f};
            pg8::gemm_phase<2 * D, false>(F.lds, F.tid, S, E);
        } if (IN(pb + 1)) SEAM(pb + 1);
        if (IN(pb + 2)) { REPLOOP(pb + 2) {
#ifndef NO_ML
            { PHASE_ENV();
#pragma unroll 1
              for (int u = F.bid; u < 256 * REP_ML; u += F.G) { Frame Fu = F; { int t_ = F.tid; asm volatile("" : "+v"(t_)); Fu.tid = t_; Fu.lane = t_ & 63; Fu.wave = __builtin_amdgcn_readfirstlane(t_ >> 6); }
                mlA_unit(Fu, u & 255, (const bf16_t*)(ws + WS_PROJ), (const float*)(ws + WS_GATES), (bf16_t*)(ws + WS_HF), (bf16_t*)(ws + WS_HB), (float*)(ws + WS_SCAL), (float*)(ws + WS_U), (float*)(ws + WS_UN), (float*)(ws + WS_AA)); } }
#endif
#ifndef NO_AT
            { PHASE_ENV();
#pragma unroll 1
              for (int u = F.bid; u < 256 * REP_AT; u += F.G) { Frame Fu = F; { int t_ = F.tid; asm volatile("" : "+v"(t_)); Fu.tid = t_; Fu.lane = t_ & 63; Fu.wave = __builtin_amdgcn_readfirstlane(t_ >> 6); }
                attn_unit(Fu, u & 255, (const bf16_t*)(ws + WS_PROJ), (const float*)(ws + WS_ROPEC), (const float*)(ws + WS_ROPES), ap->in[6] + l * 128, ap->in[7] + l * 128, ap->in[8] + l * 8, (bf16_t*)(ws + WS_MIX)); } }
#endif
            }
            SEAM(pb + 2);
        }
        if (IN(pb + 3)) REPLOOP(pb + 3) { PHASE_ENV();
            const int ngemm = (F.G >= 256) ? 128 : 0;
            if (F.bid < ngemm || ngemm == 0) { pg8::SchedPlain<D, false> S{(const bf16_t*)(ws + WS_H8), (const bf16_t*)((const unsigned char*)(ws + WS_WMO8) + (size_t)l * 1024 * D), MTOK / 256, 1024 / 256, ngemm ? ngemm : F.G, F.bid};
                pg8::EpiStoreBf16 E{(bf16_t*)(ws + WS_PROJ) + INWA, INWG, 1.0f / pg8::WSC_UP};
                pg8::gemm_phase<D, true>(F.lds, F.tid, S, E); }
            if (F.bid >= ngemm) { Frame Fb = F; Fb.bid = F.bid - ngemm; Fb.G = F.G - ngemm;
                mlB_phase(Fb, (const float*)(ws + WS_U), (const float*)(ws + WS_UN), (const float*)(ws + WS_AA), (bf16_t*)(ws + WS_CPREV), (float*)(ws + WS_NPREV)); }
        } if (IN(pb + 3)) SEAM(pb + 3);
        if (IN(pb + 4)) REPLOOP(pb + 4) { PHASE_ENV();
#pragma unroll 1
            for (int u = F.bid; u < 256; u += F.G) { Frame Fu = F; { int t_ = F.tid; asm volatile("" : "+v"(t_)); Fu.tid = t_; Fu.lane = t_ & 63; Fu.wave = __builtin_amdgcn_readfirstlane(t_ >> 6); }
                mlC_unit(Fu, u, (const bf16_t*)(ws + WS_PROJ), (const bf16_t*)(ws + WS_HF), (const bf16_t*)(ws + WS_HB), (const float*)(ws + WS_SCAL), (const bf16_t*)(ws + WS_CPREV), (const float*)(ws + WS_NPREV), ap->in[9] + l * 1024, (bf16_t*)(ws + WS_MIX)); } } if (IN(pb + 4)) SEAM(pb + 4);
        if (IN(pb + 5)) REPLOOP(pb + 5) { PHASE_ENV();
            const float* MOD = (const float*)(ws + WS_MOD) + (size_t)l * NB * 6 * D;
            pg8::SchedPlain<2 * D> S{(const bf16_t*)(ws + WS_MIX), (const bf16_t*)(ws + WS_WOUT) + (size_t)l * D * D, MTOK / 256, D / 256, F.G, F.bid};
            if (l == 0) { pg8::EpiResidual<false> E{ap->in[0], (bf16_t*)(ws + WS_X1), MOD + 2 * D}; pg8::gemm_phase<2 * D, false>(F.lds, F.tid, S, E); }
            else { pg8::EpiResidual<true> E{ws + WS_X2, (bf16_t*)(ws + WS_X1), MOD + 2 * D}; pg8::gemm_phase<2 * D, false>(F.lds, F.tid, S, E); }
        } if (IN(pb + 5)) SEAM(pb + 5);
        if (IN(pb + 6)) REPLOOP(pb + 6) { PHASE_ENV();
            const float* MOD = (const float*)(ws + WS_MOD) + (size_t)l * NB * 6 * D;
            norm_phase<1, true>(F, ws + WS_X1, MOD + 3 * D, MOD + 4 * D, (const bf16_t*)(ws + WS_W16) + (size_t)(l * 2 + 1) * 16 * D, nullptr, nullptr, (unsigned char*)(ws + WS_H8), (float*)(ws + WS_AFF)); } if (IN(pb + 6)) SEAM(pb + 6);
        if (IN(pb + 7)) REPLOOP(pb + 7) { PHASE_ENV();
            LAS int* tbl = (LAS int*)(F.lds + LDS_TBL);
            for (int i0 = 0; i0 < 8; i0 += 2) { pg8::Unit u0, u1; const bool h0 = pg8::moe_unit(F.G, F.bid, i0, u0), h1 = pg8::moe_unit(F.G, F.bid, i0 + 1, u1);
                if (!h0) break;
                const int bb[2] = {u0.pm / NE, h1 ? u1.pm / NE : 0}, ee[2] = {u0.aux, h1 ? u1.aux : 0}; const bool pub[2] = {u0.pn == 0, h1 && u1.pn == 0};
                select_pair(F, h1 ? 2 : 1, bb, ee, pub, (const float*)(ws + WS_AFF), tbl + i0 * 256, (LAS unsigned*)(F.lds + LDS_MISC + 64), (float*)(ws + WS_GATEV), (int*)(ws + WS_SLOT)); }
            pg8::SchedMoeUp S{(const unsigned char*)(ws + WS_H8), (const unsigned char*)(ws + WS_WGU) + (size_t)l * NE * 2 * FF * D, tbl, F.G, F.bid}; pg8::EpiSwiGLU E{(unsigned char*)(ws + WS_HID)};
            pg8::gemm_phase<D, true>(F.lds, F.tid, S, E); } if (IN(pb + 7)) SEAM(pb + 7);
        if (IN(pb + 8)) REPLOOP(pb + 8) { PHASE_ENV();
            pg8::SchedMoeDown S{(const unsigned char*)(ws + WS_HID), (const unsigned char*)(ws + WS_WD) + (size_t)l * NE * D * FF, F.G, F.bid}; pg8::EpiGated E{(unsigned char*)(ws + WS_YE), (const float*)(ws + WS_GATEV)};
            pg8::gemm_phase<FF, true>(F.lds, F.tid, S, E); } if (IN(pb + 8)) SEAM(pb + 8);
        if (IN(pb + 9)) REPLOOP(pb + 9) { PHASE_ENV();
            const float* MOD = (const float*)(ws + WS_MOD) + (size_t)l * NB * 6 * D;
            if (l == DEPTH - 1) combine_phase<false>(F, (const bf16_t*)(ws + WS_X1), MOD + 5 * D, (const int*)(ws + WS_SLOT), (const unsigned char*)(ws + WS_YE), ap->out);
            else combine_phase<true>(F, (const bf16_t*)(ws + WS_X1), MOD + 5 * D, (const int*)(ws + WS_SLOT), (const unsigned char*)(ws + WS_YE), ws + WS_X2);
        } if (IN(pb + 9)) SEAM(pb + 9);
    }
#undef IN
#undef SEAM
}

extern "C" void kernel_launch(void* const* d_in, const int* in_sizes, int n_in, void* d_out, int out_size, void* d_ws, size_t ws_size, hipStream_t stream) {
    static int grid = 0;
    if (grid == 0) {
        if (n_in != 15 || out_size != MTOK * D || ws_size < WS_END) { fprintf(stderr, "kernel_launch: unexpected shapes (n_in %d out %d ws %zu need %zu)\n", n_in, out_size, ws_size, (size_t)WS_END); grid = -1; return; }
        int dev = 0, cus = 0, per_cu = 0;
        if (hipGetDevice(&dev) != hipSuccess || hipDeviceGetAttribute(&cus, hipDeviceAttributeMultiprocessorCount, dev) != hipSuccess) { grid = -1; return; }
        if (hipFuncSetAttribute((const void*)hymba_fwd, hipFuncAttributeMaxDynamicSharedMemorySize, LDS_BYTES) != hipSuccess) { fprintf(stderr, "kernel_launch: hipFuncSetAttribute failed\n"); grid = -1; return; }
        if (hipOccupancyMaxActiveBlocksPerMultiprocessor(&per_cu, (const void*)hymba_fwd, NTHR, LDS_BYTES) != hipSuccess || per_cu < 1)
            fprintf(stderr, "kernel_launch: occupancy query reports %d workgroups per CU\n", per_cu);
        (void)hipGetLastError();
        grid = cus;
    }
    if (grid < 0) return;
    if (hipMemsetAsync((char*)d_ws + WS_CTL, 0, WS_ZERO_END, stream) != hipSuccess) { fprintf(stderr, "kernel_launch: memset failed\n"); return; }
    Args a{};
    for (int i = 0; i < 15; ++i) a.in[i] = (const float*)d_in[i];
    a.out = (float*)d_out; a.ws = (unsigned char*)d_ws;
#if MK_SPLIT
    for (int p = 0; p < N_PHASES; ++p) { a.ph_lo = p; a.ph_hi = p + 1; hipLaunchKernelGGL(hymba_fwd, dim3(grid), dim3(NTHR), LDS_BYTES, stream, a); }
#else
    a.ph_lo = 0; a.ph_hi = N_PHASES; hipLaunchKernelGGL(hymba_fwd, dim3(grid), dim3(NTHR), LDS_BYTES, stream, a);
#endif
    const hipError_t le = hipPeekAtLastError();
    if (le != hipSuccess) fprintf(stderr, "kernel_launch: launch failed: %s\n", hipGetErrorName(le));
}
```
